# Optimizing an MI355X kernel written in HIP

```python
import math
import jax, jax.numpy as jnp
from jax import lax
import numpy as np

D_MODEL = 1024
BATCH = 16
SEQ = 4096
DEPTH = 4

MIX_WIDTH = D_MODEL
DSA_HEADS = D_MODEL // 128
DSA_HEAD_DIM = 64
IDX_HEADS = 8
IDX_DIM = 64
TOPK_MAX = 256
DSA_Q_BLOCK = 64
DIFF_HEADS = D_MODEL // 256
DIFF_HEAD_DIM = 64
DIFF_V_DIM = 2 * DIFF_HEAD_DIM
DIFF_Q_BLOCK = 128
NUM_BUCKETS = 32
MAX_DISTANCE = 128
D_FF = ((8 * D_MODEL // 3 + 255) // 256) * 256
EPS = 1e-6

IN_WIDTHS = (
    DSA_HEADS * DSA_HEAD_DIM,
    DSA_HEADS * DSA_HEAD_DIM,
    DSA_HEADS * DSA_HEAD_DIM,
    IDX_HEADS * IDX_DIM,
    IDX_DIM,
    IDX_HEADS,
    DIFF_HEADS * 2 * DIFF_HEAD_DIM,
    DIFF_HEADS * 2 * DIFF_HEAD_DIM,
    DIFF_HEADS * DIFF_V_DIM,
)
IN_COLS = sum(IN_WIDTHS)
OUT_IN = DSA_HEADS * DSA_HEAD_DIM + DIFF_HEADS * DIFF_V_DIM

kernel_name = "hybrid_dsa_diffattn_parallel_heads"


def rms_norm(x, g):
    xf = x.astype(jnp.float32)
    y = xf * lax.rsqrt(jnp.mean(xf * xf, axis=-1, keepdims=True) + EPS)
    return (y * g.astype(jnp.float32)).astype(x.dtype)


def rel_bucket(dist):
    n = jnp.maximum(dist, 0)
    max_exact = NUM_BUCKETS // 2
    nf = jnp.maximum(n, 1).astype(jnp.float32)
    large = max_exact + (jnp.log(nf / max_exact) / math.log(MAX_DISTANCE / max_exact)
                         * (NUM_BUCKETS - max_exact)).astype(jnp.int32)
    large = jnp.minimum(large, NUM_BUCKETS - 1)
    return jnp.where(n < max_exact, n, large)


def split_cols(p, widths):
    outs, off = [], 0
    for w in widths:
        outs.append(p[..., off:off + w])
        off += w
    return outs


def dsa_mixer(q, k, v, q_idx, k_idx, w_idx, bias_tab):
    B, S, H, Dh = q.shape
    n_sel = min(TOPK_MAX, S // 4)
    n_blk = S // DSA_Q_BLOCK
    key_pos = jnp.arange(S, dtype=jnp.int32)

    def block(i):
        start = i * DSA_Q_BLOCK
        qb = lax.dynamic_slice_in_dim(q, start, DSA_Q_BLOCK, axis=1)
        qib = lax.dynamic_slice_in_dim(q_idx, start, DSA_Q_BLOCK, axis=1)
        wb = lax.dynamic_slice_in_dim(w_idx, start, DSA_Q_BLOCK, axis=1)
        q_pos = start + jnp.arange(DSA_Q_BLOCK, dtype=jnp.int32)
        dots = jnp.einsum('bqhd,bsd->bqhs', qib, k_idx) * (IDX_DIM ** -0.5)
        score = jnp.einsum('bqh,bqhs->bqs', wb * (IDX_HEADS ** -0.5), jax.nn.relu(dots))
        causal = key_pos[None, :] <= q_pos[:, None]
        score = jnp.where(causal[None], score.astype(jnp.float32), -jnp.inf)
        _, sel = lax.top_k(score, n_sel)
        valid = sel <= q_pos[None, :, None]
        flat = sel.reshape(B, -1)
        ks = jnp.take_along_axis(k, flat[:, :, None, None], axis=1).reshape(B, DSA_Q_BLOCK, n_sel, H, Dh)
        vs = jnp.take_along_axis(v, flat[:, :, None, None], axis=1).reshape(B, DSA_Q_BLOCK, n_sel, H, Dh)
        logits = jnp.einsum('bqhd,bqkhd->bqhk', qb, ks).astype(jnp.float32) * (Dh ** -0.5)
        bias = bias_tab[rel_bucket(q_pos[None, :, None] - sel)]
        logits = logits + jnp.transpose(bias, (0, 1, 3, 2)).astype(jnp.float32)
        logits = jnp.where(valid[:, :, None, :], logits, -jnp.inf)
        p = jax.nn.softmax(logits, axis=-1).astype(v.dtype)
        return jnp.einsum('bqhk,bqkhd->bqhd', p, vs)

    out = lax.map(block, jnp.arange(n_blk, dtype=jnp.int32))
    return jnp.transpose(out, (1, 0, 2, 3, 4)).reshape(B, S, H * Dh)


def diff_mixer(q, k, v, lam, lam_init, subln, bias_tab):
    B, S, Hd, _, Dd = q.shape
    n_blk = S // DIFF_Q_BLOCK
    key_pos = jnp.arange(S, dtype=jnp.int32)
    lamf = lam.astype(jnp.float32)
    lam_full = (jnp.exp(jnp.sum(lamf[0] * lamf[1])) - jnp.exp(jnp.sum(lamf[2] * lamf[3]))
                + lam_init)

    def block(i):
        start = i * DIFF_Q_BLOCK
        qb = lax.dynamic_slice_in_dim(q, start, DIFF_Q_BLOCK, axis=1)
        q_pos = start + jnp.arange(DIFF_Q_BLOCK, dtype=jnp.int32)
        logits = jnp.einsum('bqhcd,bshcd->bhcqs', qb, k).astype(jnp.float32) * (Dd ** -0.5)
        dist = q_pos[:, None] - key_pos[None, :]
        bias = jnp.transpose(bias_tab[rel_bucket(dist)], (2, 0, 1))
        logits = logits + bias[None, :, None].astype(jnp.float32)
        logits = jnp.where((dist >= 0)[None, None, None], logits, -jnp.inf)
        p = jax.nn.softmax(logits, axis=-1)
        attn = (p[:, :, 0] - lam_full * p[:, :, 1]).astype(v.dtype)
        return jnp.einsum('bhqs,bshe->bqhe', attn, v)

    out = lax.map(block, jnp.arange(n_blk, dtype=jnp.int32))
    out = jnp.transpose(out, (1, 0, 2, 3, 4)).reshape(B, S, Hd, 2 * Dd)
    out = rms_norm(out, subln) * (1.0 - lam_init)
    return out.reshape(B, S, Hd * 2 * Dd)


def setup_inputs(seed: int = 0) -> dict:
    key = jax.random.key(seed)
    ks = jax.random.split(key, 14)
    f32 = jnp.float32
    nrm = lambda k, shape, s: jax.random.normal(k, shape, f32) * s
    return {
        "x": nrm(ks[0], (BATCH, SEQ, D_MODEL), 1.0),
        "attn_norm": 1.0 + nrm(ks[1], (DEPTH, D_MODEL), 0.05),
        "w_in": nrm(ks[2], (DEPTH, D_MODEL, IN_COLS), D_MODEL ** -0.5),
        "diff_lambda": nrm(ks[3], (DEPTH, 4, DIFF_HEAD_DIM), 0.1),
        "diff_subln": 1.0 + nrm(ks[4], (DEPTH, DIFF_V_DIM), 0.05),
        "w_out": nrm(ks[5], (DEPTH, OUT_IN, D_MODEL), OUT_IN ** -0.5),
        "ffn_norm": 1.0 + nrm(ks[6], (DEPTH, D_MODEL), 0.05),
        "w_gate": nrm(ks[7], (DEPTH, D_MODEL, D_FF), D_MODEL ** -0.5),
        "w_up": nrm(ks[8], (DEPTH, D_MODEL, D_FF), D_MODEL ** -0.5),
        "w_down": nrm(ks[9], (DEPTH, D_FF, D_MODEL), D_FF ** -0.5),
        "rel_bias": nrm(ks[10], (NUM_BUCKETS, DSA_HEADS + DIFF_HEADS), 0.5),
        "final_norm": 1.0 + nrm(ks[11], (D_MODEL,), 0.05),
    }


def reference(x, attn_norm, w_in, diff_lambda, diff_subln, w_out, ffn_norm,
              w_gate, w_up, w_down, rel_bias, final_norm):
    B, S, _ = x.shape
    bias_dsa = rel_bias[:, :DSA_HEADS]
    bias_diff = rel_bias[:, DSA_HEADS:]
    for l in range(DEPTH):
        lam_init = 0.8 - 0.6 * math.exp(-0.3 * l)
        h = rms_norm(x, attn_norm[l])
        proj = jnp.einsum('bsd,dc->bsc', h, w_in[l])
        (dq, dk, dv, iq, ik, iw, fq, fk, fv) = split_cols(proj, IN_WIDTHS)
        dsa_out = dsa_mixer(
            dq.reshape(B, S, DSA_HEADS, DSA_HEAD_DIM),
            dk.reshape(B, S, DSA_HEADS, DSA_HEAD_DIM),
            dv.reshape(B, S, DSA_HEADS, DSA_HEAD_DIM),
            iq.reshape(B, S, IDX_HEADS, IDX_DIM), ik, iw, bias_dsa)
        diff_out = diff_mixer(
            fq.reshape(B, S, DIFF_HEADS, 2, DIFF_HEAD_DIM),
            fk.reshape(B, S, DIFF_HEADS, 2, DIFF_HEAD_DIM),
            fv.reshape(B, S, DIFF_HEADS, DIFF_V_DIM),
            diff_lambda[l], lam_init, diff_subln[l], bias_diff)
        mixed = jnp.concatenate([dsa_out, diff_out], axis=-1)
        x = x + jnp.einsum('bsc,cd->bsd', mixed, w_out[l])
        h = rms_norm(x, ffn_norm[l])
        g = jnp.einsum('bsd,df->bsf', h, w_gate[l])
        u = jnp.einsum('bsd,df->bsf', h, w_up[l])
        x = x + jnp.einsum('bsf,fd->bsd', jax.nn.silu(g) * u, w_down[l])
    return rms_norm(x, final_norm)
```

```cpp
#include <hip/hip_runtime.h>
#include <cstdio>
#include <cstdint>
namespace pg8 {
#define PG8_LAS __attribute__((address_space(3)))
typedef unsigned short bf16_t;
typedef short bf16x8 __attribute__((ext_vector_type(8)));
typedef float f32x4 __attribute__((ext_vector_type(4)));
typedef unsigned u32x4 __attribute__((ext_vector_type(4)));
constexpr int BM = 256, BK = 64, HALF = 128, HTB = HALF * BK * 2  , STAGE_BYTES = 8 * HTB, NXCD = 8, WGM = 8;

__host__ __device__ __forceinline__ int lds_byte(int r, int c) { const int st = (r >> 4) * 2 + (c >> 5), rr = r & 15, cc = c & 31, ob = rr * 64 + cc * 2; return st * 1024 + (ob ^ (((ob >> 9) & 1) << 5)); }
__host__ __device__ __forceinline__ void stage_rc(int b, int& R, int& C) { const int st = b / 1024, sb = b % 1024, swz = sb ^ (((sb >> 9) & 1) << 5); R = (st >> 1) * 16 + swz / 64; C = (st & 1) * 32 + (swz % 64) / 2; }
__host__ __device__ __forceinline__ int perm32(int rho) { const int n = rho >> 4, i = rho & 15; return 8 * (i >> 2) + 4 * n + (i & 3); }

struct Unit { int pm, pn; };
struct Gemm { const bf16_t* A; const bf16_t* Bt; int M, N, K; };

struct StaticOrder {
    int nM, nN, nwg, G, c;
    __host__ __device__ void init(int M, int N, int G_, int c_) { nM = M / BM; nN = N / BM; nwg = nM * nN; G = G_; c = c_; }
    __host__ __device__ bool next(int i, Unit& u) const {
        const long L = (long)i * G + c; if (L >= nwg) return false;
        int wgid = (int)L; { const int q = nwg / NXCD, r = nwg % NXCD, xcd = wgid % NXCD, off = wgid / NXCD; wgid = (xcd < r ? xcd * (q + 1) : r * (q + 1) + (xcd - r) * q) + off; }
        const int nig = WGM * nN, gid = wgid / nig, fm = gid * WGM, gsz = (nM - fm) < WGM ? (nM - fm) : WGM;
        u.pm = fm + ((wgid % nig) % gsz); u.pn = (wgid % nig) / gsz; return true;
    }
    __device__ __forceinline__ void a_ready(const Unit&) const {}
    __device__ __forceinline__ void done(const Unit&) const {}
};

__device__ __forceinline__ unsigned cvt_pk_bf16(float lo, float hi) { unsigned r; asm volatile("v_cvt_pk_bf16_f32 %0, %1, %2" : "=v"(r) : "v"(lo), "v"(hi)); return r; }
typedef float f32x2 __attribute__((ext_vector_type(2)));
typedef float f32x2 __attribute__((ext_vector_type(2)));
typedef unsigned u32x2v __attribute__((ext_vector_type(2)));
constexpr float RMS_EPS = 1e-6f;
constexpr float QSCALE = 0.125f * 1.4426950408889634f;
__device__ __forceinline__ float row_rs(const float* SS, int row) {
    const f32x4* p = (const f32x4*)(SS + (size_t)row * 16); const f32x4 a = p[0], b = p[1], c = p[2], d = p[3];
    const float s = ((a[0] + a[1]) + (a[2] + a[3])) + ((b[0] + b[1]) + (b[2] + b[3])) + ((c[0] + c[1]) + (c[2] + c[3])) + ((d[0] + d[1]) + (d[2] + d[3]));
    return __builtin_amdgcn_rsqf(s * (1.f / 1024.f) + RMS_EPS);
}
constexpr int RS_LDS_OFF = 131072;
__device__ __forceinline__ const PG8_LAS float* stage_rs(const float* SS, int row0) {
    PG8_LAS float* rb = (PG8_LAS float*)(uintptr_t)RS_LDS_OFF;
    int tid = threadIdx.x; asm volatile("" : "+v"(tid));
    if (tid < 256) rb[tid] = row_rs(SS, row0 + tid);
    asm volatile("s_waitcnt lgkmcnt(0)\n\ts_barrier" ::: "memory");
    return rb;
}
struct EpiInProj {
    static constexpr bool PERM = true, AFTER_DRAIN = false;
    bf16_t *QO, *KK, *IQ, *IK; float* IW; const float* SS;
    __device__ __forceinline__ void operator()(const f32x4 (&acc)[2][2][4][2], const Unit& u, int wr, int wc, int fr, int fq) const {
        const int row0 = u.pm * BM + wr * 64 + fr, pn = u.pn, lr0 = wr * 64 + fr;
        const PG8_LAS float* rb = stage_rs(SS, u.pm * BM);
        if (pn < 10) {
            bf16_t* base; int ldc, colt; float sc = 1.f;
            if (pn < 4) { base = QO; ldc = 1024; colt = pn * 256; sc = QSCALE; }
            else if (pn < 8) { base = KK; ldc = 1024; colt = (pn - 4) * 256; }
            else { base = IQ; ldc = 512; colt = (pn - 8) * 256; }
            const int col0 = colt + wc * 32 + 8 * fq;
#pragma unroll
            for (int ai = 0; ai < 2; ++ai)
#pragma unroll
                for (int m = 0; m < 4; ++m) { bf16_t* rowp = base + (size_t)(row0 + ai * HALF + m * 16) * ldc + col0; const float s = rb[lr0 + ai * HALF + m * 16] * sc;
#pragma unroll
                    for (int bj = 0; bj < 2; ++bj) { const f32x4 v0 = acc[ai][bj][m][0] * s, v1 = acc[ai][bj][m][1] * s;
                        u32x4 w; w.x = cvt_pk_bf16(v0[0], v0[1]); w.y = cvt_pk_bf16(v0[2], v0[3]); w.z = cvt_pk_bf16(v1[0], v1[1]); w.w = cvt_pk_bf16(v1[2], v1[3]);
                        *(u32x4*)(rowp + bj * HALF) = w; }
                    }
        } else {
            const int c = wc * 32 + 8 * fq;
#pragma unroll
            for (int ai = 0; ai < 2; ++ai)
#pragma unroll
                for (int m = 0; m < 4; ++m) { const int row = row0 + ai * HALF + m * 16; const float s = rb[lr0 + ai * HALF + m * 16];
                    const f32x4 v0 = acc[ai][0][m][0] * s, v1 = acc[ai][0][m][1] * s;
                    if (c < 64) { u32x4 w; w.x = cvt_pk_bf16(v0[0], v0[1]); w.y = cvt_pk_bf16(v0[2], v0[3]); w.z = cvt_pk_bf16(v1[0], v1[1]); w.w = cvt_pk_bf16(v1[2], v1[3]);
                        *(u32x4*)(IK + (size_t)row * 64 + c) = w; }
                    else if (c == 64) { *(f32x4*)(IW + (size_t)row * 8) = v0; *(f32x4*)(IW + (size_t)row * 8 + 4) = v1; }
                    }
        }
    }
};
struct EpiVT {
    static constexpr bool PERM = true, AFTER_DRAIN = false;
    bf16_t* VT; const float* SS;
    __device__ __forceinline__ void operator()(const f32x4 (&acc)[2][2][4][2], const Unit& u, int wr, int wc, int fr, int fq) const {
        const int row0 = u.pm * BM + wr * 64 + fr, col0 = u.pn * BM + wc * 32 + 8 * fq;
        const PG8_LAS float* rb = stage_rs(SS, u.pn * BM);
        const int pos0 = (col0 & ~15) + ((col0 & 8) ? 4 : 0);
#pragma unroll
        for (int bj = 0; bj < 2; ++bj) { float rs[8];
#pragma unroll
            for (int i = 0; i < 8; ++i) rs[i] = rb[wc * 32 + 8 * fq + bj * HALF + i];
#pragma unroll
            for (int ai = 0; ai < 2; ++ai)
#pragma unroll
                for (int m = 0; m < 4; ++m) { const f32x4 v0 = acc[ai][bj][m][0], v1 = acc[ai][bj][m][1];
                    u32x2v w0, w1; w0.x = cvt_pk_bf16(v0[0] * rs[0], v0[1] * rs[1]); w0.y = cvt_pk_bf16(v0[2] * rs[2], v0[3] * rs[3]); w1.x = cvt_pk_bf16(v1[0] * rs[4], v1[1] * rs[5]); w1.y = cvt_pk_bf16(v1[2] * rs[6], v1[3] * rs[7]);
                    bf16_t* p = VT + (size_t)(row0 + ai * HALF + m * 16) * 65536 + pos0 + bj * HALF;
                    *(u32x2v*)p = w0; *(u32x2v*)(p + 8) = w1; }
            }
    }
};
struct EpiRes {
    static constexpr bool PERM = true, AFTER_DRAIN = false;
    const float* Xf32; bf16_t* XB; float* SS;
    __device__ __forceinline__ void operator()(const f32x4 (&acc)[2][2][4][2], const Unit& u, int wr, int wc, int fr, int fq) const {
        const int row0 = u.pm * BM + wr * 64 + fr, col0 = u.pn * BM + wc * 32 + 8 * fq;
        if (Xf32) {
#pragma unroll
            for (int ai = 0; ai < 2; ++ai)
#pragma unroll
                for (int m = 0; m < 4; ++m) { const int row = row0 + ai * HALF + m * 16; const size_t off = (size_t)row * 1024 + col0; float ss = 0.f;
#pragma unroll
                    for (int bj = 0; bj < 2; ++bj) { const f32x4 x0 = *(const f32x4*)(Xf32 + off + bj * HALF), x1 = *(const f32x4*)(Xf32 + off + bj * HALF + 4);
                        const f32x4 v0 = acc[ai][bj][m][0] + x0, v1 = acc[ai][bj][m][1] + x1;
                        u32x4 w; w.x = cvt_pk_bf16(v0[0], v0[1]); w.y = cvt_pk_bf16(v0[2], v0[3]); w.z = cvt_pk_bf16(v1[0], v1[1]); w.w = cvt_pk_bf16(v1[2], v1[3]);
                        *(u32x4*)(XB + off + bj * HALF) = w;
                        ss += (v0[0] * v0[0] + v0[1] * v0[1]) + (v0[2] * v0[2] + v0[3] * v0[3]) + (v1[0] * v1[0] + v1[1] * v1[1]) + (v1[2] * v1[2] + v1[3] * v1[3]); }
                    ss += __shfl_xor(ss, 16); ss += __shfl_xor(ss, 32);
                    if (fq == 0) SS[(size_t)row * 16 + u.pn * 4 + wc] = ss;
                    asm volatile("" ::: "memory"); }
            return;
        }
#pragma unroll
        for (int ai = 0; ai < 2; ++ai) { u32x4 xb[4][2];
#pragma unroll
            for (int m = 0; m < 4; ++m)
#pragma unroll
                for (int bj = 0; bj < 2; ++bj) xb[m][bj] = *(const u32x4*)(XB + (size_t)(row0 + ai * HALF + m * 16) * 1024 + col0 + bj * HALF);
#pragma unroll
            for (int m = 0; m < 4; ++m) { const int row = row0 + ai * HALF + m * 16; const size_t off = (size_t)row * 1024 + col0; float ss = 0.f;
#pragma unroll
                for (int bj = 0; bj < 2; ++bj) { const u32x4 x = xb[m][bj];
                    const f32x4 x0 = (f32x4){__builtin_bit_cast(float, x.x << 16), __builtin_bit_cast(float, x.x & 0xffff0000u), __builtin_bit_cast(float, x.y << 16), __builtin_bit_cast(float, x.y & 0xffff0000u)};
                    const f32x4 x1 = (f32x4){__builtin_bit_cast(float, x.z << 16), __builtin_bit_cast(float, x.z & 0xffff0000u), __builtin_bit_cast(float, x.w << 16), __builtin_bit_cast(float, x.w & 0xffff0000u)};
                    const f32x4 v0 = acc[ai][bj][m][0] + x0, v1 = acc[ai][bj][m][1] + x1;
                    u32x4 w; w.x = cvt_pk_bf16(v0[0], v0[1]); w.y = cvt_pk_bf16(v0[2], v0[3]); w.z = cvt_pk_bf16(v1[0], v1[1]); w.w = cvt_pk_bf16(v1[2], v1[3]);
                    *(u32x4*)(XB + off + bj * HALF) = w;
                    ss += (v0[0] * v0[0] + v0[1] * v0[1]) + (v0[2] * v0[2] + v0[3] * v0[3]) + (v1[0] * v1[0] + v1[1] * v1[1]) + (v1[2] * v1[2] + v1[3] * v1[3]); }
                ss += __shfl_xor(ss, 16); ss += __shfl_xor(ss, 32);
                if (fq == 0) SS[(size_t)row * 16 + u.pn * 4 + wc] = ss; }
            asm volatile("" ::: "memory"); }
    }
};
struct EpiGateUp {
    static constexpr bool PERM = true, AFTER_DRAIN = false;
    bf16_t* ACT; const float* SS;
    __device__ __forceinline__ void operator()(const f32x4 (&acc)[2][2][4][2], const Unit& u, int wr, int wc, int fr, int fq) const {
        const int row0 = u.pm * BM + wr * 64 + fr, col0 = u.pn * HALF + wc * 32 + 8 * fq;
        const PG8_LAS float* rb = stage_rs(SS, u.pm * BM);
#pragma unroll
        for (int ai = 0; ai < 2; ++ai)
#pragma unroll
            for (int m = 0; m < 4; ++m) { const int row = row0 + ai * HALF + m * 16; const float s = rb[wr * 64 + fr + ai * HALF + m * 16];
                float a[8];
#pragma unroll
                for (int n = 0; n < 2; ++n)
#pragma unroll
                    for (int i = 0; i < 4; ++i) { const float g = acc[ai][0][m][n][i] * s, up = acc[ai][1][m][n][i] * s;
                        a[4 * n + i] = g * __builtin_amdgcn_rcpf(1.f + __builtin_amdgcn_exp2f(-1.4426950408889634f * g)) * up; }
                u32x4 w; w.x = cvt_pk_bf16(a[0], a[1]); w.y = cvt_pk_bf16(a[2], a[3]); w.z = cvt_pk_bf16(a[4], a[5]); w.w = cvt_pk_bf16(a[6], a[7]);
                *(u32x4*)(ACT + (size_t)row * 2816 + col0) = w; }
    }
};

template <class Epi, class Sched, bool ALIGN_EPI = false, bool SP2 = false>
__device__ __forceinline__ void gemm_phase(PG8_LAS unsigned char* lds, const Gemm g, const Sched& S, const Epi& E) {
    int tid_l = threadIdx.x; asm volatile("" : "+v"(tid_l));
    const int tid = tid_l, wid = __builtin_amdgcn_readfirstlane(tid >> 6), lane = tid & 63, wr = wid >> 2, wc = wid & 3, fr = lane & 15, fq = lane >> 4;
    const int K = g.K, nt = K / BK;
    unsigned voffA[2], voffB[2];
#pragma unroll
    for (int i = 0; i < 2; ++i) { int R, C; stage_rc(tid * 16 + i * 8192, R, C); const int Rb = Epi::PERM ? ((R & ~31) + perm32(R & 31)) : R;
        voffA[i] = (unsigned)(R * K + C) * 2u; voffB[i] = (unsigned)(Rb * K + C) * 2u; }
    const size_t kstep = (size_t)(BK * 2);
    const size_t hstep = (size_t)HALF * K * 2;
    const size_t tstep = 2 * hstep;
    const unsigned ldsw = (unsigned)wid * 1024u;
    const int aoff = lds_byte(wr * 64 + fr, fq * 8), boff = lds_byte(wc * 32 + fr, fq * 8);
#define PG8_SA(b, h) (((b) * 2 + (h)) * HTB)
#define PG8_SB(b, h) ((4 + (b) * 2 + (h)) * HTB)
#define PG8_STAGE(bufoff, gbase, voff) do { const char* gb_ = (const char*)(gbase); asm volatile("" : "+s"(gb_)); _Pragma("unroll") for (int _i = 0; _i < 2; ++_i) { asm volatile("" : "+v"((voff)[_i])); \
        __builtin_amdgcn_global_load_lds((const unsigned*)(gb_ + (voff)[_i]), (PG8_LAS unsigned*)(lds + (bufoff) + ldsw + _i * 8192), 16, 0, 0); } } while (0)
#define PG8_LDA(dst, b, h) do { _Pragma("unroll") for (int m = 0; m < 4; ++m) _Pragma("unroll") for (int k = 0; k < 2; ++k) dst[m][k] = *(const PG8_LAS bf16x8*)(lds + PG8_SA(b, h) + aoff + m * 2048 + k * 1024); } while (0)
#define PG8_LDB(dst, b, h) do { _Pragma("unroll") for (int n = 0; n < 2; ++n) _Pragma("unroll") for (int k = 0; k < 2; ++k) dst[n][k] = *(const PG8_LAS bf16x8*)(lds + PG8_SB(b, h) + boff + n * 2048 + k * 1024); } while (0)
#define PG8_MMA(ai, bj, At, Bt) do { __builtin_amdgcn_s_setprio(1); _Pragma("unroll") for (int m = 0; m < 4; ++m) _Pragma("unroll") for (int n = 0; n < 2; ++n) _Pragma("unroll") for (int k = 0; k < 2; ++k) \
        acc[ai][bj][m][n] = __builtin_amdgcn_mfma_f32_16x16x32_bf16(Bt[n][k], At[m][k], acc[ai][bj][m][n], 0, 0, 0); __builtin_amdgcn_s_setprio(0); } while (0)
#define PG8_WAIT_V(n) asm volatile("s_waitcnt vmcnt(" #n ")" ::: "memory")
#define PG8_WAIT_L(n) asm volatile("s_waitcnt lgkmcnt(" #n ")" ::: "memory")
#define PG8_BAR __builtin_amdgcn_s_barrier()
#define PG8_SCHED __builtin_amdgcn_sched_barrier(0)
    Unit cur, nxt; int ui = 0;
    if (!S.next(0, cur)) return;
    f32x4 acc[2][2][4][2];
#pragma unroll
    for (int a = 0; a < 2; ++a)
#pragma unroll
        for (int b = 0; b < 2; ++b)
#pragma unroll
            for (int m = 0; m < 4; ++m)
#pragma unroll
                for (int n = 0; n < 2; ++n) acc[a][b][m][n] = (f32x4){0.f, 0.f, 0.f, 0.f};
    bf16x8 At[4][2], B0[2][2], B1[2][2];
    const char* cA = (const char*)g.A + (size_t)cur.pm * tstep; const char* cB = (const char*)g.Bt + (size_t)cur.pn * tstep;
    S.a_ready(cur);
    if constexpr (SP2) {
        PG8_STAGE(PG8_SB(0, 0), cB, voffB); PG8_STAGE(PG8_SB(0, 1), cB + hstep, voffB); PG8_STAGE(PG8_SA(0, 0), cA, voffA); PG8_STAGE(PG8_SA(0, 1), cA + hstep, voffA);
        if (wr == 1) PG8_BAR;
        PG8_WAIT_V(2); PG8_BAR;
        PG8_STAGE(PG8_SB(1, 0), cB + kstep, voffB); PG8_STAGE(PG8_SA(1, 0), cA + kstep, voffA); PG8_STAGE(PG8_SB(1, 1), cB + hstep + kstep, voffB);
        PG8_WAIT_V(6); PG8_BAR;
    } else {
        PG8_STAGE(PG8_SB(0, 0), cB, voffB); PG8_STAGE(PG8_SA(0, 0), cA, voffA); PG8_STAGE(PG8_SB(0, 1), cB + hstep, voffB); PG8_STAGE(PG8_SA(0, 1), cA + hstep, voffA);
        if (wr == 1) PG8_BAR;
        PG8_WAIT_V(4); PG8_BAR;
        PG8_STAGE(PG8_SB(1, 0), cB + kstep, voffB); PG8_STAGE(PG8_SA(1, 0), cA + kstep, voffA); PG8_STAGE(PG8_SB(1, 1), cB + hstep + kstep, voffB);
        PG8_WAIT_V(6); PG8_BAR;
    }
    for (;;) {
        const bool has_next = S.next(ui + 1, nxt);
        const char* nA = has_next ? (const char*)g.A + (size_t)nxt.pm * tstep : cA; const char* nB = has_next ? (const char*)g.Bt + (size_t)nxt.pn * tstep : cB;
        for (int t = 0; t < nt; t += 2) {
            const bool last = (t == nt - 2);
            const char* a1 = cA + (size_t)(t + 1) * kstep;
            const char* a2 = last ? nA : cA + (size_t)(t + 2) * kstep; const char* b2 = last ? nB : cB + (size_t)(t + 2) * kstep;
            const char* a3 = a2 + kstep; const char* b3 = b2 + kstep;
            if (last && has_next) S.a_ready(nxt);
            if constexpr (SP2) {
            PG8_LDB(B0, 0, 0); PG8_LDB(B1, 0, 1); PG8_SCHED; PG8_LDA(At, 0, 0); PG8_STAGE(PG8_SA(1, 1), a1 + hstep, voffA);
            PG8_WAIT_V(8); PG8_WAIT_L(0); PG8_BAR; PG8_MMA(0, 0, At, B0); PG8_MMA(0, 1, At, B1); PG8_BAR; PG8_SCHED;
            PG8_LDA(At, 0, 1); PG8_STAGE(PG8_SB(0, 0), b2, voffB); PG8_STAGE(PG8_SB(0, 1), b2 + hstep, voffB); PG8_STAGE(PG8_SA(0, 0), a2, voffA);
            PG8_WAIT_V(8); PG8_WAIT_L(0); PG8_BAR; PG8_MMA(1, 0, At, B0); PG8_MMA(1, 1, At, B1); PG8_BAR; PG8_SCHED;
            PG8_LDB(B0, 1, 0); PG8_LDB(B1, 1, 1); PG8_SCHED; PG8_LDA(At, 1, 0); PG8_STAGE(PG8_SA(0, 1), a2 + hstep, voffA);
            PG8_WAIT_V(8); PG8_WAIT_L(0); PG8_BAR; PG8_MMA(0, 0, At, B0); PG8_MMA(0, 1, At, B1); PG8_BAR; PG8_SCHED;
            PG8_LDA(At, 1, 1); PG8_STAGE(PG8_SB(1, 0), b3, voffB); PG8_STAGE(PG8_SB(1, 1), b3 + hstep, voffB); PG8_STAGE(PG8_SA(1, 0), a3, voffA);
            PG8_WAIT_V(8); PG8_WAIT_L(0); PG8_BAR; PG8_MMA(1, 0, At, B0); PG8_MMA(1, 1, At, B1); PG8_BAR; PG8_SCHED;
            } else {
            PG8_LDB(B0, 0, 0); PG8_SCHED; PG8_LDA(At, 0, 0); PG8_STAGE(PG8_SA(1, 1), a1 + hstep, voffA);
            PG8_WAIT_L(8); PG8_BAR; PG8_WAIT_L(0); PG8_MMA(0, 0, At, B0); PG8_BAR; PG8_SCHED;
            PG8_LDB(B1, 0, 1); PG8_STAGE(PG8_SB(0, 0), b2, voffB);
            PG8_BAR; PG8_WAIT_L(0); PG8_MMA(0, 1, At, B1); PG8_BAR;
            PG8_LDA(At, 0, 1); PG8_STAGE(PG8_SA(0, 0), a2, voffA);
            PG8_BAR; PG8_WAIT_L(0); PG8_MMA(1, 0, At, B0); PG8_BAR; PG8_SCHED;
            PG8_STAGE(PG8_SB(0, 1), b2 + hstep, voffB);
            PG8_WAIT_V(6); PG8_BAR; PG8_MMA(1, 1, At, B1); PG8_BAR;
            PG8_LDB(B0, 1, 0); PG8_SCHED; PG8_LDA(At, 1, 0); PG8_STAGE(PG8_SA(0, 1), a2 + hstep, voffA);
            PG8_WAIT_L(8); PG8_BAR; PG8_WAIT_L(0); PG8_MMA(0, 0, At, B0); PG8_BAR; PG8_SCHED;
            PG8_LDB(B1, 1, 1); PG8_STAGE(PG8_SB(1, 0), b3, voffB);
            PG8_BAR; PG8_WAIT_L(0); PG8_MMA(0, 1, At, B1); PG8_BAR;
            PG8_LDA(At, 1, 1); PG8_STAGE(PG8_SA(1, 0), a3, voffA);
            PG8_BAR; PG8_WAIT_L(0); PG8_MMA(1, 0, At, B0); PG8_BAR; PG8_SCHED;
            PG8_STAGE(PG8_SB(1, 1), b3 + hstep, voffB);
            PG8_WAIT_V(6); PG8_BAR; PG8_MMA(1, 1, At, B1); PG8_BAR;
            }
        }
        if constexpr (ALIGN_EPI) { if (wr == 0) PG8_BAR; }
        if constexpr (!Epi::AFTER_DRAIN) { E(acc, cur, wr, wc, fr, fq); S.done(cur); }
        if (!has_next) break;
#pragma unroll
        for (int a = 0; a < 2; ++a)
#pragma unroll
            for (int b = 0; b < 2; ++b)
#pragma unroll
                for (int m = 0; m < 4; ++m)
#pragma unroll
                    for (int n = 0; n < 2; ++n) acc[a][b][m][n] = (f32x4){0.f, 0.f, 0.f, 0.f};
        cur = nxt; cA = nA; cB = nB; ++ui;
        if constexpr (ALIGN_EPI) { if (wr == 1) PG8_BAR; }
    }
    PG8_WAIT_V(0);
    if constexpr (!ALIGN_EPI) { if (wr == 0) PG8_BAR; }
    PG8_BAR;
    if constexpr (Epi::AFTER_DRAIN) { E.fused(acc, cur, wr, wc, fr, fq, lds, wid, lane); S.done(cur); }
#undef PG8_SA
#undef PG8_SB
#undef PG8_STAGE
#undef PG8_LDA
#undef PG8_LDB
#undef PG8_MMA
#undef PG8_WAIT_V
#undef PG8_WAIT_L
#undef PG8_BAR
#undef PG8_SCHED
}
}
constexpr int NWAVES = 8;
constexpr int BATCH = 16, SEQ = 4096, DM = 1024, DEPTH = 4, M = BATCH * SEQ;
constexpr int IN_COLS = 3656, NIN = 3840, NIN_MAIN = 2816  , NIN_V = 1024  , DFF = 2816, NGU = 2 * DFF;
constexpr int NPH = 2 + 6 * DEPTH;
#ifndef PROBE_ATT
#define PROBE_ATT 1
#endif
#ifndef PROBE_GU
#define PROBE_GU 1
#endif
#ifndef PROBE_IDX
#define PROBE_IDX 1
#endif
#ifndef MK_PER_PHASE
#define MK_PER_PHASE 0
#endif
constexpr size_t MiB = 1u << 20;
constexpr size_t WS_CTL = 0, CTL_ZERO_BYTES = 1 * MiB;
constexpr size_t WS_WIN = 2 * MiB, WS_WOUT = 32 * MiB, WS_WGU = 40 * MiB, WS_WDN = 84 * MiB;
constexpr size_t WS_SS = 106 * MiB, WS_IW = 110 * MiB, WS_IK = 112 * MiB;
constexpr size_t WS_XB = 128 * MiB, WS_QO = 256 * MiB, WS_KK = 384 * MiB, WS_VT = 512 * MiB, WS_IQ = 640 * MiB, WS_MASK = 704 * MiB, WS_ACT = 384 * MiB, WS_MIX = 736 * MiB, WS_END = 864 * MiB;
static_assert(WS_WIN + (size_t)DEPTH * NIN * DM * 2 <= WS_WOUT && WS_WOUT + (size_t)DEPTH * DM * DM * 2 <= WS_WGU && WS_WGU + (size_t)DEPTH * NGU * DM * 2 <= WS_WDN && WS_WDN + (size_t)DEPTH * DM * DFF * 2 <= WS_SS, "weights map");
static_assert(WS_ACT + (size_t)M * DFF * 2 <= WS_MIX && WS_MASK + (size_t)M * 512 <= WS_MIX && WS_MIX + (size_t)M * 1024 * 2 <= WS_END && WS_IQ + (size_t)M * 512 * 2 <= WS_MASK && WS_KK + (size_t)M * 1024 * 2 <= WS_VT && WS_VT + (size_t)M * 1024 * 2 <= WS_IQ, "activation map");
constexpr int CW_BAR = 4096;
constexpr int RING_OFF = 0, RING_BYTES = 131072, WSCR_OFF = 131072  , BIAS_OFF = 147456  , BIAS_LD = 132, MISC_OFF = 154112, LDS_BYTES = 155648;

#define GAS __attribute__((address_space(1)))
#define LAS __attribute__((address_space(3)))
typedef unsigned short bf16;
typedef unsigned v4u __attribute__((ext_vector_type(4)));
typedef float f32x4 __attribute__((ext_vector_type(4)));
typedef GAS unsigned gu32;
#define LDS_WAIT() asm volatile("s_waitcnt lgkmcnt(0)" ::: "memory")
#define VM_WAIT() asm volatile("s_waitcnt vmcnt(0)" ::: "memory")
__device__ __forceinline__ unsigned f2bf(float f) { unsigned u = __builtin_bit_cast(unsigned, f); return (u + 0x7fffu + ((u >> 16) & 1u)) >> 16; }
__device__ __forceinline__ unsigned pk2(float lo, float hi) { return f2bf(lo) | (f2bf(hi) << 16); }
__device__ __forceinline__ float bf2f(unsigned h) { return __builtin_bit_cast(float, h << 16); }
__device__ __forceinline__ float bflo(unsigned w) { return __builtin_bit_cast(float, w << 16); }
__device__ __forceinline__ float bfhi(unsigned w) { return __builtin_bit_cast(float, w & 0xffff0000u); }
__device__ __forceinline__ float wave_sum(float v) {
#pragma unroll
    for (int o = 1; o < 64; o <<= 1) v += __shfl_xor(v, o);
    return v;
}
__device__ __forceinline__ int wave_sum_i(int v) {
#pragma unroll
    for (int o = 1; o < 64; o <<= 1) v += __shfl_xor(v, o);
    return v;
}
__device__ __forceinline__ float wave_max(float v) {
#pragma unroll
    for (int o = 1; o < 64; o <<= 1) v = fmaxf(v, __shfl_xor(v, o));
    return v;
}
__device__ __forceinline__ unsigned ukey(float f) { const unsigned b = __builtin_bit_cast(unsigned, f); return b ^ ((b >> 31) ? 0xFFFFFFFFu : 0x80000000u); }
__device__ const unsigned char T5_BUCKET[128] = {0, 1, 2, 3, 4, 5, 6, 7, 8, 9, 10, 11, 12, 13, 14, 15, 16, 16, 16, 17, 17, 18, 18, 18, 19, 19, 19, 20, 20, 20, 20, 21, 21, 21, 21, 22, 22, 22, 22, 22, 23, 23, 23, 23, 23, 23, 24, 24, 24, 24, 24, 24, 25, 25, 25, 25, 25, 25, 25, 26, 26, 26, 26, 26, 26, 26, 26, 27, 27, 27, 27, 27, 27, 27, 27, 27, 27, 28, 28, 28, 28, 28, 28, 28, 28, 28, 28, 29, 29, 29, 29, 29, 29, 29, 29, 29, 29, 29, 29, 30, 30, 30, 30, 30, 30, 30, 30, 30, 30, 30, 30, 30, 30, 31, 31, 31, 31, 31, 31, 31, 31, 31, 31, 31, 31, 31, 31, 31};
__device__ __forceinline__ const char* uni_ptr(const char* p) { const unsigned long long v = (unsigned long long)p; const unsigned lo = __builtin_amdgcn_readfirstlane((unsigned)v), hi = __builtin_amdgcn_readfirstlane((unsigned)(v >> 32)); return (const char*)(((unsigned long long)hi << 32) | lo); }
#define XB_TMO      128
#define XB_XCNT(j)  (256  + 64 * (j))
#define XB_XSUB(j)  (1280 + 64 * (j))
#define XB_XGEN(j)  (2304 + 64 * (j))
#define XB_TOP      3328
#define XB_TOPGEN   3392
#define XCD_BAR_WORDS 3456
#define XB_SPIN_CAP (1u << 18)

__device__ __forceinline__ unsigned xb_ld(unsigned* p)              { return __hip_atomic_load(p, __ATOMIC_RELAXED, __HIP_MEMORY_SCOPE_AGENT); }
__device__ __forceinline__ unsigned xb_add(unsigned* p, unsigned v) { return __hip_atomic_fetch_add(p, v, __ATOMIC_RELAXED, __HIP_MEMORY_SCOPE_AGENT); }
__device__ __forceinline__ unsigned xb_xcc_id() { return (unsigned)__builtin_amdgcn_s_getreg((3 << 11) | 20) & 0xFu; }
#define XB_SPIN(cond, bar) do { unsigned _sp = 0; while (cond) { __builtin_amdgcn_s_sleep(1); \
    if ((++_sp & 255u) == 0u) { if (xb_ld(&(bar)[XB_TMO])) break; if (_sp > XB_SPIN_CAP) { atomicAdd(&(bar)[XB_TMO], 1u); break; } } } } while (0)

struct XcdBarrier {
    unsigned* bar; unsigned x;
    volatile LAS unsigned* st;
};

__device__ __forceinline__ XcdBarrier xcd_barrier_post(unsigned* bar, volatile LAS unsigned* st) {
    XcdBarrier b; b.bar = bar; b.x = xb_xcc_id(); b.st = st;
    if (threadIdx.x == 0) (void)xb_add(&bar[XB_XCNT(b.x)], 1u);
    return b;
}
__device__ __forceinline__ void xcd_barrier_complete(unsigned* bar, unsigned x, unsigned& nloc, unsigned& nx) {
    const unsigned G = gridDim.x * gridDim.y * gridDim.z;
    unsigned sum, cnt, mine, sp = 0u;
    for (;;) {
        sum = 0u; cnt = 0u; mine = 0u;
#pragma unroll
        for (unsigned j = 0; j < 16; ++j) { const unsigned c = xb_ld(&bar[XB_XCNT(j)]); sum += c; cnt += (c > 0u) ? 1u : 0u; mine = (j == x) ? c : mine; }
        if (sum == G) break;
        __builtin_amdgcn_s_sleep(1);
        if ((++sp & 255u) == 0u) { if (xb_ld(&bar[XB_TMO])) break; if (sp > XB_SPIN_CAP) { atomicAdd(&bar[XB_TMO], 1u); break; } }
    }
    nloc = mine > 0u ? mine : 1u; nx = cnt > 0u ? cnt : 1u;
}

__device__ __forceinline__ void xcd_barrier(const XcdBarrier& b) {
    asm volatile("s_waitcnt vmcnt(0)" ::: "memory");
    __syncthreads();
    if (threadIdx.x == 0) {
        unsigned* bar = b.bar; unsigned bx = b.x; asm volatile("" : "+s"(bar), "+s"(bx));
        __builtin_amdgcn_s_waitcnt(0);
        unsigned nloc = b.st[0], nx = b.st[1];
        if (nloc == 0u) { xcd_barrier_complete(bar, bx, nloc, nx); b.st[0] = nloc; b.st[1] = nx; }
        const unsigned old = xb_add(&bar[XB_XSUB(bx)], 1u);
        const unsigned gen = old / nloc;
        if (old + 1u == (gen + 1u) * nloc) {
            __builtin_amdgcn_fence(__ATOMIC_RELEASE, "agent");
            asm volatile("s_waitcnt vmcnt(0)" ::: "memory");
            const unsigned og = xb_add(&bar[XB_TOP], 1u);
            const unsigned tg = og / nx;
            if (og + 1u == (tg + 1u) * nx) xb_add(&bar[XB_TOPGEN], 1u);
            else XB_SPIN(xb_ld(&bar[XB_TOPGEN]) == tg, bar);
            __builtin_amdgcn_fence(__ATOMIC_ACQUIRE, "agent");
            xb_add(&bar[XB_XGEN(bx)], 1u);
            asm volatile("s_waitcnt vmcnt(0)" ::: "memory");
        } else {
            XB_SPIN(xb_ld(&bar[XB_XGEN(bx)]) == gen, bar);
            __builtin_amdgcn_fence(__ATOMIC_ACQUIRE, "agent");
            asm volatile("s_waitcnt vmcnt(0)" ::: "memory");
        }
    }
    __syncthreads();
}
struct TrArgs { const float* W; const float* gain; bf16* WT; int K, N, c0, nvalid, n0, k0; };
__device__ __forceinline__ void tr_load(const TrArgs& A, float (&v)[32], float (&g8)[8], int lane) {
    const int cc = lane & 31, c = lane & 7;
#pragma unroll
    for (int j = 0; j < 8; ++j) g8[j] = A.gain ? A.gain[A.k0 + 8 * c + j] : 1.f;
#pragma unroll
    for (int i = 0; i < 32; ++i) { const int kk = 2 * i + (lane >> 5); v[i] = (cc < A.nvalid) ? A.W[(size_t)(A.k0 + kk) * A.N + A.c0 + cc] : 0.f; }
}
__device__ __forceinline__ void tr_store(const TrArgs& A, const float (&v)[32], const float (&g8)[8], LAS float* scr, int lane) {
    const int cc = lane & 31, c = lane & 7;
#pragma unroll
    for (int i = 0; i < 32; ++i) scr[(2 * i + (lane >> 5)) * 33 + cc] = v[i];
    LDS_WAIT();
#pragma unroll
    for (int j = 0; j < 4; ++j) { const int n = (lane >> 3) + 8 * j; const LAS float* s = scr + (8 * c) * 33 + n;
        v4u o; o.x = pk2(s[0 * 33] * g8[0], s[1 * 33] * g8[1]); o.y = pk2(s[2 * 33] * g8[2], s[3 * 33] * g8[3]); o.z = pk2(s[4 * 33] * g8[4], s[5 * 33] * g8[5]); o.w = pk2(s[6 * 33] * g8[6], s[7 * 33] * g8[7]);
        *(GAS v4u*)(A.WT + (size_t)(A.n0 + n) * A.K + A.k0 + 8 * c) = o; }
    LDS_WAIT();
}
struct Ptrs {
    const float *x, *attn_norm, *w_in, *diff_lambda, *diff_subln, *w_out, *ffn_norm, *w_gate, *w_up, *w_down, *rel_bias, *final_norm; float* out;
    bf16 *WIN, *WOUT, *WGU, *WDN, *IK, *XB, *QO, *KK, *VT, *IQ, *ACT, *MIX; float *SS, *IW; unsigned* MASK;
};
__device__ __forceinline__ void prologue(const Ptrs& P, LAS unsigned char* lds, int gw, int NGW, int wave, int lane) {
    LAS float* scr = (LAS float*)(lds + RING_OFF + wave * 16384);
    constexpr int I_IN = (NIN / 32) * (DM / 64), I_OUT = (DM / 32) * (DM / 64), I_GU = (NGU / 32) * (DM / 64), I_DN = (DM / 32) * (DFF / 64), I_L = I_IN + I_OUT + I_GU + I_DN;
    auto decode = [&](int it) -> TrArgs {
        TrArgs A; const int l = it / I_L; int r = it % I_L;
        if (r < I_IN) { const int db = r / (DM / 64), kb = r % (DM / 64); int c0 = 0, nv = 32;
            if (db < 16) c0 = 32 * db; else if (db < 32) c0 = 2120 + 32 * (db - 16); else if (db < 48) c0 = 512 + 32 * (db - 32); else if (db < 64) c0 = 2632 + 32 * (db - 48);
            else if (db < 80) c0 = 1536 + 32 * (db - 64); else if (db < 82) c0 = 2048 + 32 * (db - 80); else if (db == 82) { c0 = 2112; nv = 8; } else if (db < 88) { c0 = 0; nv = 0; }
            else if (db < 104) c0 = 1024 + 32 * (db - 88); else c0 = 3144 + 32 * (db - 104);
            A.W = P.w_in + (size_t)l * DM * IN_COLS; A.K = DM; A.N = IN_COLS; A.c0 = c0; A.nvalid = nv; A.gain = P.attn_norm + l * DM; A.WT = P.WIN + (size_t)l * NIN * DM; A.n0 = 32 * db; A.k0 = 64 * kb; return A; }
        r -= I_IN;
        if (r < I_OUT) { const int db = r / (DM / 64), kb = r % (DM / 64);
            A.W = P.w_out + (size_t)l * DM * DM; A.K = DM; A.N = DM; A.c0 = 32 * db; A.nvalid = 32; A.gain = nullptr; A.WT = P.WOUT + (size_t)l * DM * DM; A.n0 = 32 * db; A.k0 = 64 * kb; return A; }
        r -= I_OUT;
        if (r < I_GU) { const int db = r / (DM / 64), kb = r % (DM / 64), pn = db >> 3, wb = db & 7;
            A.W = (wb < 4 ? P.w_gate : P.w_up) + (size_t)l * DM * DFF; A.K = DM; A.N = DFF; A.c0 = 128 * pn + 32 * (wb & 3); A.nvalid = 32; A.gain = P.ffn_norm + l * DM; A.WT = P.WGU + (size_t)l * NGU * DM; A.n0 = 32 * db; A.k0 = 64 * kb; return A; }
        r -= I_GU;
        { const int db = r / (DFF / 64), kb = r % (DFF / 64);
            A.W = P.w_down + (size_t)l * DFF * DM; A.K = DFF; A.N = DM; A.c0 = 32 * db; A.nvalid = 32; A.gain = nullptr; A.WT = P.WDN + (size_t)l * DM * DFF; A.n0 = 32 * db; A.k0 = 64 * kb; return A; }
    };
    {
        constexpr int TOTAL = DEPTH * I_L;
        int it = gw; TrArgs A = decode(it < TOTAL ? it : 0); float v[32], g8[8];
        if (it < TOTAL) tr_load(A, v, g8, lane);
        for (; it < TOTAL; it += NGW) {
            const int itn = it + NGW; const bool hn = itn < TOTAL; TrArgs B = decode(hn ? itn : 0); float vn[32], gn[8];
            if (hn) tr_load(B, vn, gn, lane);
            tr_store(A, v, g8, scr, lane);
            if (hn) { A = B;
#pragma unroll
                for (int i = 0; i < 32; ++i) v[i] = vn[i];
#pragma unroll
                for (int i = 0; i < 8; ++i) g8[i] = gn[i]; }
        }
    }
    for (int m0 = 4 * gw; m0 < M; m0 += 4 * NGW) {
        f32x4 xv[4][4];
#pragma unroll
        for (int rr = 0; rr < 4; ++rr) { const GAS f32x4* xr = (const GAS f32x4*)(P.x + (size_t)(m0 + rr) * DM) + lane;
#pragma unroll
            for (int j = 0; j < 4; ++j) xv[rr][j] = xr[64 * j]; }
#pragma unroll
        for (int rr = 0; rr < 4; ++rr) { GAS unsigned long long* o8 = (GAS unsigned long long*)(P.XB + (size_t)(m0 + rr) * DM) + lane; float s = 0.f;
#pragma unroll
            for (int j = 0; j < 4; ++j) { const f32x4 v = xv[rr][j]; s += (v.x * v.x + v.y * v.y) + (v.z * v.z + v.w * v.w);
                o8[64 * j] = (unsigned long long)pk2(v.x, v.y) | ((unsigned long long)pk2(v.z, v.w) << 32); }
            s = wave_sum(s);
            if (lane < 16) P.SS[(size_t)(m0 + rr) * 16 + lane] = lane == 0 ? s : 0.f; }
    }
}
__device__ __forceinline__ void final_norm_phase(const Ptrs& P, int gw, int NGW, int lane) {
    f32x4 gg[4];
#pragma unroll
    for (int j = 0; j < 4; ++j) gg[j] = ((const GAS f32x4*)P.final_norm + lane)[64 * j];
    for (int m0 = 4 * gw; m0 < M; m0 += 4 * NGW) {
        unsigned long long xv[4][4]; float r[4];
#pragma unroll
        for (int rr = 0; rr < 4; ++rr) { const GAS unsigned long long* xr = (const GAS unsigned long long*)(P.XB + (size_t)(m0 + rr) * DM) + lane;
#pragma unroll
            for (int j = 0; j < 4; ++j) xv[rr][j] = xr[64 * j]; }
#pragma unroll
        for (int rr = 0; rr < 4; ++rr) r[rr] = pg8::row_rs(P.SS, m0 + rr);
#pragma unroll
        for (int rr = 0; rr < 4; ++rr) { GAS f32x4* o = (GAS f32x4*)(P.out + (size_t)(m0 + rr) * DM) + lane;
#pragma unroll
            for (int j = 0; j < 4; ++j) { const unsigned lo = (unsigned)xv[rr][j], hi = (unsigned)(xv[rr][j] >> 32);
                o[64 * j] = (f32x4){bflo(lo) * r[rr] * gg[j].x, bfhi(lo) * r[rr] * gg[j].y, bflo(hi) * r[rr] * gg[j].z, bfhi(hi) * r[rr] * gg[j].w}; } }
    }
}
namespace idx {
typedef short bf16x8 __attribute__((ext_vector_type(8)));
typedef float f32x4v __attribute__((ext_vector_type(4)));
typedef float f32x32 __attribute__((ext_vector_type(32)));
constexpr int KSTR = 128, CHUNK = 128, CBUF = CHUNK * KSTR, K_OFF = 0, NSL = 4, CAND_OFF = NSL * CBUF  , IDX_LDS = CAND_OFF + 8 * 8192;
#define IDX_BAR() asm volatile("s_waitcnt lgkmcnt(0)\n\ts_barrier" ::: "memory")
__device__ __forceinline__ float relu(float x) { float r; asm("v_max_f32_e32 %0, 0, %1" : "=v"(r) : "v"(x)); return r; }
__device__ __forceinline__ float min3f(float a, float b, float c) { float r; asm("v_min3_f32 %0, %1, %2, %3" : "=v"(r) : "v"(a), "v"(b), "v"(c)); return r; }
__device__ __forceinline__ float max3g(float a, float b, float c) { float r; asm("v_max3_f32 %0, %1, %2, %3" : "=v"(r) : "v"(a), "v"(b), "v"(c)); return r; }
__device__ __forceinline__ float minf_s(float a, float b) { float r; asm("v_min_f32_e32 %0, %1, %2" : "=v"(r) : "v"(a), "v"(b)); return r; }
__device__ __forceinline__ float maxf_s(float a, float b) { float r; asm("v_max_f32_e32 %0, %1, %2" : "=v"(r) : "v"(a), "v"(b)); return r; }
__device__ __forceinline__ float rfl(float x) { return __builtin_bit_cast(float, __builtin_amdgcn_readfirstlane(__builtin_bit_cast(int, x))); }
#define WRL(m, val, ln) asm("v_writelane_b32 %0, %1, %2" : "+v"(m) : "s"(val), "n"(ln))
__device__ __forceinline__ int cnt8(float s0, float s1, float s2, float s3, float s4, float s5, float s6, float s7, float thr) {
    unsigned long long m0, m1, m2, m3, m4, m5, m6, m7;
    asm("v_cmp_ge_f32_e64 %0, %8, %16\n\tv_cmp_ge_f32_e64 %1, %9, %16\n\tv_cmp_ge_f32_e64 %2, %10, %16\n\tv_cmp_ge_f32_e64 %3, %11, %16\n\t"
        "v_cmp_ge_f32_e64 %4, %12, %16\n\tv_cmp_ge_f32_e64 %5, %13, %16\n\tv_cmp_ge_f32_e64 %6, %14, %16\n\tv_cmp_ge_f32_e64 %7, %15, %16"
        : "=&s"(m0), "=&s"(m1), "=&s"(m2), "=&s"(m3), "=&s"(m4), "=&s"(m5), "=&s"(m6), "=&s"(m7)
        : "v"(s0), "v"(s1), "v"(s2), "v"(s3), "v"(s4), "v"(s5), "v"(s6), "v"(s7), "v"(thr));
    return (__builtin_popcountll(m0) + __builtin_popcountll(m1)) + (__builtin_popcountll(m2) + __builtin_popcountll(m3)) + (__builtin_popcountll(m4) + __builtin_popcountll(m5)) + (__builtin_popcountll(m6) + __builtin_popcountll(m7));
}
#define CNT8(v, g, thr) cnt8(v[8 * (g)], v[8 * (g) + 1], v[8 * (g) + 2], v[8 * (g) + 3], v[8 * (g) + 4], v[8 * (g) + 5], v[8 * (g) + 6], v[8 * (g) + 7], thr)
template <int MODE> __device__ __forceinline__ void idx_unit(const Ptrs& P, int b, int grp, bool pf, int nb, int ngrp, bool& have, bf16x8& qa0, bf16x8& qa1, f32x4v& w4, LAS unsigned char* lds, int tid, int wave, int lane) {
    asm volatile("" : "+v"(tid), "+v"(lane));
    const int t0 = 16 * grp, nkeys = t0 + 16;
    if (nkeys <= 256) {
        const int tq = t0 + 2 * wave + (lane >> 5), l32 = lane & 31;
        GAS unsigned* mrow = (GAS unsigned*)(P.MASK + (size_t)(b * SEQ + tq) * 128);
#pragma unroll
        for (int i = 0; i < 4; ++i) { const int j = l32 + 32 * i, k0 = 32 * j; mrow[j] = (k0 + 31 <= tq) ? 0xFFFFFFFFu : (k0 > tq ? 0u : ((1u << (tq - k0 + 1)) - 1u)); }
        return;
    }
    const int nch = (nkeys + CHUNK - 1) / CHUNK, tq0 = t0 + 2 * wave, tq1 = tq0 + 1;
    const int srow = 16 * wave + (lane >> 3);
    const int kcol = ((lane & 7) ^ ((srow >> 1) & 7)) * 8, kcol2 = ((lane & 7) ^ (((srow + 8) >> 1) & 7)) * 8;
    unsigned ko1 = (unsigned)(srow * 64 + kcol) * 2u, ko2 = (unsigned)((srow + 8) * 64 + kcol2) * 2u;
    const char* kg = uni_ptr((const char*)(P.IK + (size_t)b * SEQ * 64));
#define IDX_DMA2(kga, c) do { const int sl_ = (c) & (NSL - 1); const char* cb_ = (kga) + (size_t)(c) * (CHUNK * 128); asm volatile("" : "+s"(cb_)); asm volatile("" : "+v"(ko1)); asm volatile("" : "+v"(ko2)); \
        __builtin_amdgcn_global_load_lds((const unsigned*)(cb_ + ko1), (LAS unsigned*)(lds + K_OFF + sl_ * CBUF + wave * 2048), 16, 0, 0); \
        __builtin_amdgcn_global_load_lds((const unsigned*)(cb_ + ko2), (LAS unsigned*)(lds + K_OFF + sl_ * CBUF + wave * 2048 + 1024), 16, 0, 0); } while (0)
#define IDX_DMA(c) IDX_DMA2(kg, c)
#define IDX_OPERANDS(bb, tq) do { const int m_ = lane & 15, kq_ = lane >> 4, g_ = lane >> 4; const bf16* qp_ = P.IQ + (size_t)((bb) * SEQ + (tq) + (m_ >> 3)) * 512 + (m_ & 7) * 64 + 8 * kq_; \
        qa0 = *(const bf16x8*)qp_; qa1 = *(const bf16x8*)(qp_ + 32); w4 = *(const f32x4v*)(P.IW + (size_t)((bb) * SEQ + (tq) + (g_ >> 1)) * 8 + 4 * (g_ & 1)); } while (0)
    if (!have) { IDX_OPERANDS(b, tq0); IDX_DMA(0); IDX_DMA(1); IDX_DMA(2); asm volatile("" : "+v"(qa0), "+v"(qa1), "+v"(w4)); }
    asm volatile("s_waitcnt vmcnt(4)" ::: "memory");
    __builtin_amdgcn_s_barrier();
    bf16x8 qa[2] = {qa0, qa1}; float wv[4] = {w4[0], w4[1], w4[2], w4[3]};
    f32x32 a0, a1, b0, b1;
#pragma unroll
    for (int i = 0; i < 32; ++i) { a0[i] = -INFINITY; a1[i] = -INFINITY; b0[i] = -INFINITY; b1[i] = -INFINITY; }
    float mn0 = INFINITY, mn1 = INFINITY, mx0 = -INFINITY, mx1 = -INFINITY;
    const LAS unsigned char* kb = lds + K_OFF + (lane & 15) * KSTR + (((lane >> 4) ^ ((lane >> 1) & 7)) * 16);
    const int kx = (int)(((unsigned)(size_t)kb ^ 64u) - (unsigned)(size_t)kb);
#define IDX_SB() __builtin_amdgcn_sched_barrier(0)
#define IDX_MF(a, b, c) __builtin_amdgcn_mfma_f32_16x16x32_bf16(a, b, c, 0, 0, 0)
#define IDX_RL(x) x = __int_as_float(max(__float_as_int(x), 0))
#define IDX_LOADF(f0, f1, f2, f3, p) do { const LAS unsigned char* p_ = (p); f0 = *(const LAS bf16x8*)p_; f1 = *(const LAS bf16x8*)(p_ + kx); f2 = *(const LAS bf16x8*)(p_ + 16 * KSTR); f3 = *(const LAS bf16x8*)(p_ + 16 * KSTR + kx); } while (0)
#define IDX_KEEP(f0, f1, f2, f3) asm volatile("" :: "v"(f0), "v"(f1), "v"(f2), "v"(f3), "v"(ta0), "v"(ta1))
#define IDX_STEP(dn0, dn1, f0, f1, f2, f3, do0, do1) do { const f32x4v z_ = {0.f, 0.f, 0.f, 0.f}; \
        ta0 = IDX_MF(qa[0], f0, z_); IDX_SB(); IDX_RL(do0[0]); IDX_RL(do0[1]); IDX_SB(); \
        ta1 = IDX_MF(qa[0], f2, z_); IDX_SB(); IDX_RL(do0[2]); IDX_RL(do0[3]); IDX_SB(); \
        dn0 = IDX_MF(qa[1], f1, ta0); IDX_SB(); IDX_RL(do1[0]); IDX_RL(do1[1]); IDX_SB(); \
        dn1 = IDX_MF(qa[1], f3, ta1); IDX_SB(); IDX_RL(do1[2]); IDX_RL(do1[3]); IDX_SB(); } while (0)
#define IDX_SUM(r, d0, d1) do { float p0_ = wv[0] * d0[0]; p0_ = __builtin_fmaf(wv[1], d0[1], p0_); p0_ = __builtin_fmaf(wv[2], d0[2], p0_); p0_ = __builtin_fmaf(wv[3], d0[3], p0_); \
        float p1_ = wv[0] * d1[0]; p1_ = __builtin_fmaf(wv[1], d1[1], p1_); p1_ = __builtin_fmaf(wv[2], d1[2], p1_); p1_ = __builtin_fmaf(wv[3], d1[3], p1_); \
        auto rr_ = __builtin_amdgcn_permlane16_swap(__float_as_uint(p0_), __float_as_uint(p1_), false, false); r = __uint_as_float(rr_[0]) + __uint_as_float(rr_[1]); } while (0)
#define IDX_FIN(re, ro, va, vb, koff) do { auto ss_ = __builtin_amdgcn_permlane32_swap(__float_as_uint(re), __float_as_uint(ro), false, false); float A_ = __uint_as_float(ss_[0]), B_ = __uint_as_float(ss_[1]); \
        mn0 = minf_s(mn0, A_); mn1 = minf_s(mn1, B_); \
        if (CHUNK * c + CHUNK - 1 > t0) { const int k_ = CHUNK * c + (koff) + lane; A_ = k_ > tq0 ? -INFINITY : A_; B_ = k_ > tq1 ? -INFINITY : B_; } \
        mx0 = maxf_s(mx0, A_); mx1 = maxf_s(mx1, B_); va[c] = A_; vb[c] = B_; } while (0)
    bf16x8 fa0, fa1, fa2, fa3, fb0, fb1, fb2, fb3; f32x4v da0, da1, db0, db1, ta0, ta1; float re, ro;
    IDX_LOADF(fa0, fa1, fa2, fa3, kb);
    for (int c = 0; c < nch; ++c) {
        const LAS unsigned char* kc = kb + (c & (NSL - 1)) * CBUF;
        IDX_LOADF(fb0, fb1, fb2, fb3, kc + 32 * KSTR);
        IDX_SB();
        { const f32x4v z_ = {0.f, 0.f, 0.f, 0.f}; da0 = IDX_MF(qa[0], fa0, z_); da1 = IDX_MF(qa[0], fa2, z_); da0 = IDX_MF(qa[1], fa1, da0); da1 = IDX_MF(qa[1], fa3, da1); }
        IDX_SB();
        if (c + 3 < nch) IDX_DMA(c + 3);
        IDX_SB();
        IDX_STEP(db0, db1, fb0, fb1, fb2, fb3, da0, da1);
        IDX_LOADF(fa0, fa1, fa2, fa3, kc + 64 * KSTR); IDX_KEEP(fb0, fb1, fb2, fb3);
        IDX_SUM(re, da0, da1);
        IDX_SB();
        IDX_STEP(da0, da1, fa0, fa1, fa2, fa3, db0, db1);
        IDX_LOADF(fb0, fb1, fb2, fb3, kc + 96 * KSTR); IDX_KEEP(fa0, fa1, fa2, fa3);
        IDX_SUM(ro, db0, db1);
        IDX_FIN(re, ro, a0, b0, 0);
        IDX_SB();
        IDX_STEP(db0, db1, fb0, fb1, fb2, fb3, da0, da1);
        IDX_SUM(re, da0, da1);
        if (c + 3 < nch) asm volatile("s_waitcnt vmcnt(4) lgkmcnt(0)" ::: "memory"); else asm volatile("s_waitcnt vmcnt(0) lgkmcnt(0)" ::: "memory");
        __builtin_amdgcn_s_barrier();
        IDX_LOADF(fa0, fa1, fa2, fa3, kb + ((c + 1) & (NSL - 1)) * CBUF); IDX_KEEP(fb0, fb1, fb2, fb3);
        IDX_SB();
        IDX_RL(db0[0]); IDX_RL(db0[1]); IDX_RL(db0[2]); IDX_RL(db0[3]); IDX_RL(db1[0]); IDX_RL(db1[1]); IDX_RL(db1[2]); IDX_RL(db1[3]);
        IDX_SUM(ro, db0, db1);
        IDX_FIN(re, ro, a1, b1, 64);
    }
    asm volatile("s_waitcnt lgkmcnt(0)" :: "v"(fa0), "v"(fa1), "v"(fa2), "v"(fa3) : "memory");
#undef IDX_SB
#undef IDX_MF
#undef IDX_RL
#undef IDX_LOADF
#undef IDX_KEEP
#undef IDX_STEP
#undef IDX_SUM
#undef IDX_FIN
    have = false;
    if (pf) { const char* kgn = uni_ptr((const char*)(P.IK + (size_t)nb * SEQ * 64));
        IDX_OPERANDS(nb, 16 * ngrp + 2 * wave); IDX_DMA2(kgn, 0); IDX_DMA2(kgn, 1); IDX_DMA2(kgn, 2); have = true; }
#undef IDX_DMA
#undef IDX_DMA2
#undef IDX_OPERANDS
    if (MODE == 1) { float* dump = (float*)(P.MIX) + (size_t)M * 512 + ((size_t)(b * 256 + grp) * 512 + tid) * 4;
        float sa = 0.f, sb = 0.f;
#pragma unroll
        for (int i = 0; i < 32; ++i) { sa += a0[i] + a1[i]; sb += b0[i] + b1[i]; }
        dump[0] = sa; dump[1] = sb; dump[2] = mn0 + mx0; dump[3] = mn1 + mx1; return; }
#pragma unroll
    for (int m = 1; m < 64; m <<= 1) { mn0 = fminf(mn0, __shfl_xor(mn0, m)); mn1 = fminf(mn1, __shfl_xor(mn1, m)); mx0 = fmaxf(mx0, __shfl_xor(mx0, m)); mx1 = fmaxf(mx1, __shfl_xor(mx1, m)); }
    float lo0 = rfl(mn0), lo1 = rfl(mn1), hi0 = rfl(mx0), hi1 = rfl(mx1), thr0 = lo0, thr1 = lo1;
    hi0 += fmaxf(fabsf(hi0) * 1e-6f, 1e-30f); hi1 += fmaxf(fabsf(hi1) * 1e-6f, 1e-30f);
    constexpr int CAND = 512;
    bool done0 = false, done1 = false; int clo0 = tq0 + 1, clo1 = tq1 + 1, chi0 = 0, chi1 = 0;
    for (int it = 0; it < 64; ++it) {
        if ((done0 || clo0 - chi0 <= CAND) && (done1 || clo1 - chi1 <= CAND)) break;
        const float mid0 = 0.5f * lo0 + 0.5f * hi0, mid1 = 0.5f * lo1 + 0.5f * hi1;
        if (!done0 && (mid0 <= lo0 || mid0 >= hi0)) { thr0 = lo0; done0 = true; }
        if (!done1 && (mid1 <= lo1 || mid1 >= hi1)) { thr1 = lo1; done1 = true; }
        if (done0 && done1) break;
        int c0 = 0, c1 = 0;
#pragma unroll
        for (int g = 0; g < 4; ++g) if (nch > 8 * g) {
            c0 += CNT8(a0, g, mid0) + CNT8(a1, g, mid0); c1 += CNT8(b0, g, mid1) + CNT8(b1, g, mid1); }
        if (!done0) { if (c0 == 256) { thr0 = mid0; done0 = true; } else if (c0 > 256) { lo0 = mid0; clo0 = c0; } else { hi0 = mid0; chi0 = c0; } }
        if (!done1) { if (c1 == 256) { thr1 = mid1; done1 = true; } else if (c1 > 256) { lo1 = mid1; clo1 = c1; } else { hi1 = mid1; chi1 = c1; } }
    }
    LAS float* cl0 = (LAS float*)(lds + CAND_OFF + wave * 8192); LAS float* cl1 = cl0 + 1024;
    int m0 = 0, m1 = 0;
#define IDX_COMPACT(v, lo, hi, list, m) do { const float v_ = (v); const bool in_ = (v_ >= (lo)) && (v_ < (hi)); const unsigned long long bm_ = __ballot(in_); \
        if (bm_) { const int pre_ = __builtin_amdgcn_mbcnt_hi((unsigned)(bm_ >> 32), __builtin_amdgcn_mbcnt_lo((unsigned)bm_, 0u)); if (in_) (list)[(m) + pre_] = v_; (m) += __builtin_popcountll(bm_); } } while (0)
    if (!done0) {
#pragma unroll
        for (int c = 0; c < 32; ++c) if (c < nch) { IDX_COMPACT(a0[c], lo0, hi0, cl0, m0); IDX_COMPACT(a1[c], lo0, hi0, cl0, m0); } }
    if (!done1) {
#pragma unroll
        for (int c = 0; c < 32; ++c) if (c < nch) { IDX_COMPACT(b0[c], lo1, hi1, cl1, m1); IDX_COMPACT(b1[c], lo1, hi1, cl1, m1); } }
#undef IDX_COMPACT
    LDS_WAIT();
    float cr0[8], cr1[8];
#pragma unroll
    for (int k = 0; k < 8; ++k) { const int i = 64 * k + lane; cr0[k] = (i < m0) ? cl0[i] : -INFINITY; cr1[k] = (i < m1) ? cl1[i] : -INFINITY; }
    LDS_WAIT();
    const int k0 = 256 - chi0, k1 = 256 - chi1;
    for (int it = 0; it < 64; ++it) {
        const float mid0 = 0.5f * lo0 + 0.5f * hi0, mid1 = 0.5f * lo1 + 0.5f * hi1;
        if (!done0 && (mid0 <= lo0 || mid0 >= hi0)) { thr0 = lo0; done0 = true; }
        if (!done1 && (mid1 <= lo1 || mid1 >= hi1)) { thr1 = lo1; done1 = true; }
        if (done0 && done1) break;
        const int c0 = cnt8(cr0[0], cr0[1], cr0[2], cr0[3], cr0[4], cr0[5], cr0[6], cr0[7], mid0);
        const int c1 = cnt8(cr1[0], cr1[1], cr1[2], cr1[3], cr1[4], cr1[5], cr1[6], cr1[7], mid1);
        if (!done0) { if (c0 == k0) { thr0 = mid0; done0 = true; } else if (c0 > k0) lo0 = mid0; else hi0 = mid0; }
        if (!done1) { if (c1 == k1) { thr1 = mid1; done1 = true; } else if (c1 > k1) lo1 = mid1; else hi1 = mid1; }
    }
    if (!done0) thr0 = lo0;
    if (!done1) thr1 = lo1;
    if (MODE == 2) { float* dump = (float*)(P.MIX) + (size_t)M * 512 + ((size_t)(b * 256 + grp) * 512 + tid) * 4; dump[0] = thr0; dump[1] = thr1; return; }
    if (have) asm volatile("" : "+v"(qa0), "+v"(qa1), "+v"(w4));
    unsigned m0a = 0u, m0b = 0u, m1a = 0u, m1b = 0u;
#pragma unroll
    for (int c = 0; c < 32; ++c) if (c < nch) {
        const unsigned long long e0 = __ballot(a0[c] >= thr0), e1 = __ballot(a1[c] >= thr0), f0 = __ballot(b0[c] >= thr1), f1 = __ballot(b1[c] >= thr1);
        if (c < 16) { WRL(m0a, (unsigned)e0, 4 * c); WRL(m0a, (unsigned)(e0 >> 32), 4 * c + 1); WRL(m0a, (unsigned)e1, 4 * c + 2); WRL(m0a, (unsigned)(e1 >> 32), 4 * c + 3);
                      WRL(m1a, (unsigned)f0, 4 * c); WRL(m1a, (unsigned)(f0 >> 32), 4 * c + 1); WRL(m1a, (unsigned)f1, 4 * c + 2); WRL(m1a, (unsigned)(f1 >> 32), 4 * c + 3); }
        else { const int cc = c - 16;
               WRL(m0b, (unsigned)e0, 4 * cc); WRL(m0b, (unsigned)(e0 >> 32), 4 * cc + 1); WRL(m0b, (unsigned)e1, 4 * cc + 2); WRL(m0b, (unsigned)(e1 >> 32), 4 * cc + 3);
               WRL(m1b, (unsigned)f0, 4 * cc); WRL(m1b, (unsigned)(f0 >> 32), 4 * cc + 1); WRL(m1b, (unsigned)f1, 4 * cc + 2); WRL(m1b, (unsigned)(f1 >> 32), 4 * cc + 3); }
    }
    { GAS unsigned* r0 = (GAS unsigned*)(P.MASK + (size_t)(b * SEQ + tq0) * 128); GAS unsigned* r1 = (GAS unsigned*)(P.MASK + (size_t)(b * SEQ + tq1) * 128);
      r0[lane] = m0a; r0[64 + lane] = m0b; r1[lane] = m1a; r1[64 + lane] = m1b; }
}
template <int MODE> __device__ __forceinline__ void idx_phase(const Ptrs& P, LAS unsigned char* lds, int bid, int G, int tid, int wave, int lane) {
    for (int vb = bid; vb < 256; vb += G) {
        const int vcu = (vb & 7) * 32 + (vb >> 3);
        bf16x8 qa0, qa1; f32x4v w4; bool have = false;
        for (int b = 0; b < BATCH; ++b) { const int grp = (b & 1) ? 255 - vcu : vcu, nb = b + 1, ngrp = (nb & 1) ? 255 - vcu : vcu;
            idx_unit<MODE>(P, b, grp, nb < BATCH && 16 * ngrp + 16 > 256, nb, ngrp, have, qa0, qa1, w4, lds, tid, wave, lane); }
    }
}
#undef IDX_BAR
}

namespace att {
typedef short bf16x8 __attribute__((ext_vector_type(8)));
typedef float f32x16 __attribute__((ext_vector_type(16)));
typedef unsigned u32x2 __attribute__((ext_vector_type(2)));
typedef float f32x2v __attribute__((ext_vector_type(2)));
constexpr int NSLOT = 4, KSLOT = 8192, VSLOT = 16384;
constexpr int K_OFF = 0, V_OFF = NSLOT * KSLOT, WSF_OFF = V_OFF + NSLOT * VSLOT, OST_OFF = V_OFF  , MSK_OFF = WSF_OFF + 8 * 256  , ATT_LDS = MSK_OFF + 8 * 4096;
__device__ __forceinline__ int crow(int r, int hi) { return (r & 3) + 8 * (r >> 2) + 4 * hi; }
#define ATT_BAR() asm volatile("s_waitcnt lgkmcnt(0)\n\ts_barrier" ::: "memory")
__device__ __forceinline__ float swap_max(float m) { auto rr = __builtin_amdgcn_permlane32_swap(__float_as_uint(m), __float_as_uint(m), false, false); return fmaxf(__uint_as_float(rr[0]), __uint_as_float(rr[1])); }
__device__ __forceinline__ float swap_sum(float m) { auto rr = __builtin_amdgcn_permlane32_swap(__float_as_uint(m), __float_as_uint(m), false, false); return __uint_as_float(rr[0]) + __uint_as_float(rr[1]); }
__device__ __forceinline__ unsigned cvtpk(float lo, float hi) { unsigned r; asm("v_cvt_pk_bf16_f32 %0, %1, %2" : "=v"(r) : "v"(lo), "v"(hi)); return r; }
__device__ __forceinline__ float fadd_s(float a, float b) { float r; asm("v_add_f32_e32 %0, %1, %2" : "=v"(r) : "v"(a), "v"(b)); return r; }
__device__ __forceinline__ float fsub_s(float a, float b) { float r; asm("v_sub_f32_e32 %0, %1, %2" : "=v"(r) : "v"(a), "v"(b)); return r; }
__device__ __forceinline__ float max3f(float a, float b, float c) { float r; asm("v_max3_f32 %0, %1, %2, %3" : "=v"(r) : "v"(a), "v"(b), "v"(c)); return r; }
__device__ __forceinline__ int med3i(int a, int b, int c) { int r; asm("v_med3_i32 %0, %1, %2, %3" : "=v"(r) : "v"(a), "v"(b), "v"(c)); return r; }
__device__ __forceinline__ unsigned bfe1(unsigned w, int c) { unsigned r; asm("v_bfe_i32 %0, %1, %2, 1" : "=v"(r) : "v"(w), "n"(c)); return r; }
typedef float f32x2m __attribute__((ext_vector_type(2)));
typedef __bf16 bf16x2m __attribute__((ext_vector_type(2)));
__device__ __forceinline__ unsigned cvtpk_m(float lo, float hi) { const f32x2m v = {lo, hi}; const bf16x2m b = __builtin_convertvector(v, bf16x2m); return __builtin_bit_cast(unsigned, b); }
__device__ __forceinline__ bf16x8 pack8m(const f32x16& p, int b) { v4u w; w.x = cvtpk_m(p[b], p[b + 1]); w.y = cvtpk_m(p[b + 2], p[b + 3]); w.z = cvtpk_m(p[b + 4], p[b + 5]); w.w = cvtpk_m(p[b + 6], p[b + 7]); return __builtin_bit_cast(bf16x8, w); }
__device__ __forceinline__ bf16x8 pack8(const f32x16& p, int b) { v4u w; w.x = cvtpk(p[b], p[b + 1]); w.y = cvtpk(p[b + 2], p[b + 3]); w.z = cvtpk(p[b + 4], p[b + 5]); w.w = cvtpk(p[b + 6], p[b + 7]); return __builtin_bit_cast(bf16x8, w); }

template <int DV, bool MASKED>
__device__ __forceinline__ void attn_pass(f32x16 (&o)[DV / 32], const bf16* Q, const bf16* K, const bf16* VT, const unsigned* MASKb, const LAS float* bias,
                                          int q0, int nt, LAS unsigned char* lds, int tid, int wave, int lane) {
    asm volatile("" : "+v"(tid), "+v"(lane));
    const int r32 = lane & 31, hi = lane >> 5, qw0 = q0 + 32 * wave, qpos = qw0 + r32, tmax = (qw0 + 31) >> 6;
    bf16x8 qf[4];
#pragma unroll
    for (int s = 0; s < 4; ++s) qf[s] = *(const bf16x8*)(Q + (size_t)qpos * 1024 + 16 * s + 8 * hi);
    const int srow = 8 * wave + (lane >> 3), spc = ((lane & 7) ^ ((srow >> 1) & 7)) * 8;
    unsigned koff = (unsigned)(srow * 1024 + spc) * 2u, voff = (unsigned)(srow * M + spc) * 2u, moff = (unsigned)qpos * 512u;
    const char* Ku = uni_ptr((const char*)K); const char* Vu = uni_ptr((const char*)VT); const char* Mu = MASKED ? uni_ptr((const char*)MASKb) : nullptr;
    LAS float* wsf = (LAS float*)(lds + WSF_OFF + wave * 256);
    constexpr bool SPLIT = !MASKED && DV == 128;
    constexpr int KV_OPS = 1 + DV / 64 + (MASKED ? 1 : 0);
    static_assert(KV_OPS == 3, "the counted waits assume three LDS-DMA operations per tile per wave");
#define ATT_VB(v) asm volatile("" : "+v"(v))
#define ATT_SB(p) asm volatile("" : "+s"(p))
#define ATT_DMA(t) do { const int sl_ = (t) & (NSLOT - 1); \
        if (MASKED) { const char* mb_ = Mu + (size_t)(16 * ((t) >> 1)); ATT_SB(mb_); ATT_VB(moff); __builtin_amdgcn_global_load_lds((const unsigned*)(mb_ + moff), (LAS unsigned*)(lds + MSK_OFF + wave * 4096 + sl_ * 1024), 16, 0, 0); } \
        { const char* kb_ = Ku + (size_t)(t) * 131072; ATT_SB(kb_); ATT_VB(koff); __builtin_amdgcn_global_load_lds((const unsigned*)(kb_ + koff), (LAS unsigned*)(lds + K_OFF + sl_ * KSLOT + wave * 1024), 16, 0, 0); } \
        _Pragma("unroll") for (int i_ = 0; i_ < DV / 64; ++i_) { const char* vb_ = Vu + ((size_t)i_ * 128 * M + (size_t)(t) * 128); ATT_SB(vb_); ATT_VB(voff); \
            __builtin_amdgcn_global_load_lds((const unsigned*)(vb_ + voff), (LAS unsigned*)(lds + V_OFF + sl_ * VSLOT + i_ * 8192 + wave * 1024), 16, 0, 0); } } while (0)
    asm volatile("s_waitcnt lgkmcnt(0)\n\ts_barrier" ::: "memory");
    ATT_DMA(0);
    if (nt > 1) ATT_DMA(1);
    if (nt > 2) ATT_DMA(2);
    int xo[4];
#pragma unroll
    for (int s = 0; s < 4; ++s) xo[s] = r32 * 128 + (((2 * s + hi) ^ ((r32 >> 1) & 7)) * 16);
    if (nt > 2) asm volatile("s_waitcnt vmcnt(3)" ::: "memory");
    else asm volatile("s_waitcnt vmcnt(0)" ::: "memory");
    __builtin_amdgcn_s_barrier();
    bf16x8 kf[8];
#pragma unroll
    for (int s = 0; s < 4; ++s) { kf[2 * s] = *(const LAS bf16x8*)(lds + K_OFF + xo[s]); kf[2 * s + 1] = *(const LAS bf16x8*)(lds + K_OFF + xo[s] + 4096); }
    float lsum = 0.f, one = 1.f; asm volatile("" : "+v"(one));
    f32x16 negm;
#pragma unroll
    for (int r = 0; r < 16; ++r) negm[r] = 0.f;
#pragma unroll
    for (int d0 = 0; d0 < DV / 32; ++d0)
#pragma unroll
        for (int r = 0; r < 16; ++r) o[d0][r] = 0.f;
    for (int t = 0; t < nt; ++t) {
        const int slot = t & (NSLOT - 1);
        if (t <= tmax) {
            f32x16 p0, p1;
            const LAS unsigned char* vb = lds + V_OFF + slot * VSLOT;
            bf16x8 vf[8], vg2[DV == 128 ? 8 : 1]; u32x2 mw = {0u, 0u};
            __builtin_amdgcn_sched_barrier(0);
#pragma unroll
            for (int s = 0; s < 4; ++s) { p0 = __builtin_amdgcn_mfma_f32_32x32x16_bf16(kf[2 * s], qf[s], s == 0 ? negm : p0, 0, 0, 0); p1 = __builtin_amdgcn_mfma_f32_32x32x16_bf16(kf[2 * s + 1], qf[s], s == 0 ? negm : p1, 0, 0, 0); }
            __builtin_amdgcn_sched_barrier(0);
            if (t + 3 < nt) { ATT_DMA(t + 3); __builtin_amdgcn_sched_barrier(0); asm volatile("s_nop 7" : "+v"(p0), "+v"(p1)); }
            else asm volatile("s_nop 15" : "+v"(p0), "+v"(p1));
            __builtin_amdgcn_sched_barrier(0);
            const int kv0 = 64 * t;
            if (kv0 + 63 + 113 > qw0) {
                const int dq = qpos - kv0 - 4 * hi + 1;
#pragma unroll
                for (int r = 0; r < 16; ++r) { const int d = dq - ((r & 3) + 8 * (r >> 2));
                    p0[r] += bias[med3i(d, 0, 128)]; p1[r] += bias[med3i(d - 32, 0, 128)]; }
            }
            float rm;
            { float a = max3f(p0[0], p0[1], p1[0]), b = max3f(p0[2], p0[3], p1[1]); a = max3f(a, p1[2], p1[3]);
#pragma unroll
              for (int r = 4; r < 16; r += 4) { a = max3f(a, p0[r], p0[r + 1]); b = max3f(b, p0[r + 2], p0[r + 3]); a = max3f(a, p1[r], p1[r + 1]); b = max3f(b, p1[r + 2], p1[r + 3]); }
              rm = swap_max(max3f(a, b, b)); }
            if (__any(rm > 8.f) || t == 0) {
                const float dl = (t == 0) ? (rm == -INFINITY ? 0.f : rm) : fmaxf(rm, 0.f), f = (t == 0) ? 1.f : __builtin_amdgcn_exp2f(-dl); lsum *= f;
#pragma unroll
                for (int r = 0; r < 16; ++r) negm[r] -= dl;
#pragma unroll
                for (int r = 0; r < 16; ++r) { p0[r] -= dl; p1[r] -= dl; }
                if (hi == 0) wsf[r32] = f;
                LDS_WAIT();
#pragma unroll
                for (int r = 0; r < 16; ++r) { const float fr = wsf[crow(r, hi)];
#pragma unroll
                    for (int d0 = 0; d0 < DV / 32; ++d0) o[d0][r] *= fr; }
                LDS_WAIT();
            }
            if (DV == 64) {
#pragma unroll
            for (int j = 0; j < 4; ++j) { vf[j] = *(const LAS bf16x8*)(vb + xo[j]); vf[4 + j] = *(const LAS bf16x8*)(vb + xo[j] + 4096); } }
            if (DV == 128) {
#pragma unroll
                for (int j = 0; j < 4; ++j) { vg2[DV == 128 ? j : 0] = *(const LAS bf16x8*)(vb + xo[j] + 8192); vg2[DV == 128 ? 4 + j : 0] = *(const LAS bf16x8*)(vb + xo[j] + 12288); } }
            if (SPLIT) {
#pragma unroll
            for (int j = 0; j < 4; ++j) { vf[j] = *(const LAS bf16x8*)(vb + xo[j]); vf[4 + j] = *(const LAS bf16x8*)(vb + xo[j] + 4096); } }
            if (DV == 128 && !SPLIT) {
            if (t + 1 < nt) { const LAS unsigned char* kn = lds + K_OFF + ((t + 1) & (NSLOT - 1)) * KSLOT;
#pragma unroll
                for (int s = 0; s < 4; ++s) { kf[2 * s] = *(const LAS bf16x8*)(kn + xo[s]); kf[2 * s + 1] = *(const LAS bf16x8*)(kn + xo[s] + 4096); } }
            }
            bf16x8 pa0, pa1, pa2, pa3;
            if (MASKED) {
#pragma unroll
            for (int r = 0; r < 16; ++r) { p0[r] = __builtin_amdgcn_exp2f(p0[r]); p1[r] = __builtin_amdgcn_exp2f(p1[r]); }
            } else {
            if (SPLIT) {
#pragma unroll
            for (int r = 0; r < 16; ++r) p0[r] = __builtin_amdgcn_exp2f(p0[r]);
            float sa = p0[0];
#pragma unroll
            for (int r = 1; r < 16; ++r) sa += p0[r];
            pa0 = pack8m(p0, 0); pa1 = pack8m(p0, 8);
            lsum += sa;
            } else {
#pragma unroll
            for (int r = 0; r < 16; ++r) { p0[r] = __builtin_amdgcn_exp2f(p0[r]); p1[r] = __builtin_amdgcn_exp2f(p1[r]); }
            float sa = p0[0], sb = p1[0];
#pragma unroll
            for (int r = 1; r < 16; ++r) { sa += p0[r]; sb = __builtin_fmaf(p1[r], one, sb); }
            pa0 = pack8m(p0, 0); pa1 = pack8m(p0, 8); pa2 = pack8m(p1, 0); pa3 = pack8m(p1, 8);
            lsum += sa + sb;
            }
            }
            if (MASKED) { mw = *(const LAS u32x2*)(lds + MSK_OFF + wave * 4096 + slot * 1024 + r32 * 16 + (t & 1) * 8); const unsigned w0 = mw.x >> (4 * hi), w1 = mw.y >> (4 * hi);
                p0[0] = __uint_as_float(__float_as_uint(p0[0]) & bfe1(w0, 0)); p1[0] = __uint_as_float(__float_as_uint(p1[0]) & bfe1(w1, 0));
                p0[1] = __uint_as_float(__float_as_uint(p0[1]) & bfe1(w0, 1)); p1[1] = __uint_as_float(__float_as_uint(p1[1]) & bfe1(w1, 1));
                p0[2] = __uint_as_float(__float_as_uint(p0[2]) & bfe1(w0, 2)); p1[2] = __uint_as_float(__float_as_uint(p1[2]) & bfe1(w1, 2));
                p0[3] = __uint_as_float(__float_as_uint(p0[3]) & bfe1(w0, 3)); p1[3] = __uint_as_float(__float_as_uint(p1[3]) & bfe1(w1, 3));
                p0[4] = __uint_as_float(__float_as_uint(p0[4]) & bfe1(w0, 8)); p1[4] = __uint_as_float(__float_as_uint(p1[4]) & bfe1(w1, 8));
                p0[5] = __uint_as_float(__float_as_uint(p0[5]) & bfe1(w0, 9)); p1[5] = __uint_as_float(__float_as_uint(p1[5]) & bfe1(w1, 9));
                p0[6] = __uint_as_float(__float_as_uint(p0[6]) & bfe1(w0, 10)); p1[6] = __uint_as_float(__float_as_uint(p1[6]) & bfe1(w1, 10));
                p0[7] = __uint_as_float(__float_as_uint(p0[7]) & bfe1(w0, 11)); p1[7] = __uint_as_float(__float_as_uint(p1[7]) & bfe1(w1, 11));
                p0[8] = __uint_as_float(__float_as_uint(p0[8]) & bfe1(w0, 16)); p1[8] = __uint_as_float(__float_as_uint(p1[8]) & bfe1(w1, 16));
                p0[9] = __uint_as_float(__float_as_uint(p0[9]) & bfe1(w0, 17)); p1[9] = __uint_as_float(__float_as_uint(p1[9]) & bfe1(w1, 17));
                p0[10] = __uint_as_float(__float_as_uint(p0[10]) & bfe1(w0, 18)); p1[10] = __uint_as_float(__float_as_uint(p1[10]) & bfe1(w1, 18));
                p0[11] = __uint_as_float(__float_as_uint(p0[11]) & bfe1(w0, 19)); p1[11] = __uint_as_float(__float_as_uint(p1[11]) & bfe1(w1, 19));
                p0[12] = __uint_as_float(__float_as_uint(p0[12]) & bfe1(w0, 24)); p1[12] = __uint_as_float(__float_as_uint(p1[12]) & bfe1(w1, 24));
                p0[13] = __uint_as_float(__float_as_uint(p0[13]) & bfe1(w0, 25)); p1[13] = __uint_as_float(__float_as_uint(p1[13]) & bfe1(w1, 25));
                p0[14] = __uint_as_float(__float_as_uint(p0[14]) & bfe1(w0, 26)); p1[14] = __uint_as_float(__float_as_uint(p1[14]) & bfe1(w1, 26));
                p0[15] = __uint_as_float(__float_as_uint(p0[15]) & bfe1(w0, 27)); p1[15] = __uint_as_float(__float_as_uint(p1[15]) & bfe1(w1, 27));
            }
            if (MASKED) { float sa = fadd_s(p0[0], p1[0]), sb = fadd_s(p0[1], p1[1]);
#pragma unroll
              for (int r = 2; r < 16; r += 2) { sa = fadd_s(sa, p0[r]); sb = fadd_s(sb, p0[r + 1]); sa = fadd_s(sa, p1[r]); sb = fadd_s(sb, p1[r + 1]); }
              lsum += sa + sb;
              pa0 = pack8(p0, 0); pa1 = pack8(p0, 8); pa2 = pack8(p1, 0); pa3 = pack8(p1, 8); }
            __builtin_amdgcn_sched_barrier(0);
            if (DV != 128) {
            if (t + 1 < nt) { const LAS unsigned char* kn = lds + K_OFF + ((t + 1) & (NSLOT - 1)) * KSLOT;
#pragma unroll
                for (int s = 0; s < 4; ++s) { kf[2 * s] = *(const LAS bf16x8*)(kn + xo[s]); kf[2 * s + 1] = *(const LAS bf16x8*)(kn + xo[s] + 4096); } }
            }
            if (DV == 128 && !SPLIT) {
#pragma unroll
            for (int j = 0; j < 4; ++j) { vf[j] = *(const LAS bf16x8*)(vb + xo[j]); vf[4 + j] = *(const LAS bf16x8*)(vb + xo[j] + 4096); } }
            __builtin_amdgcn_sched_barrier(0);
            if (SPLIT) {
                float sa = 0.f, f0 = 0.f, f1 = 0.f; unsigned w0 = 0u, w1 = 0u, w2 = 0u, w3 = 0u, w4 = 0u, w5 = 0u, w6 = 0u, w7 = 0u;
#define ATT_W(k, v) do { if ((k) == 0) w0 = (v); else if ((k) == 1) w1 = (v); else if ((k) == 2) w2 = (v); else if ((k) == 3) w3 = (v); else if ((k) == 4) w4 = (v); else if ((k) == 5) w5 = (v); else if ((k) == 6) w6 = (v); else w7 = (v); } while (0)
#pragma unroll
                for (int k = 0; k < 8; ++k) {
                    const int j = (k >> 1) & 1, d = (k < 4 ? 2 : 0) + (k & 1);
                    o[DV == 128 ? d : 0] = __builtin_amdgcn_mfma_f32_32x32x16_bf16(j == 0 ? pa0 : pa1, d < 2 ? vf[4 * (d & 1) + j] : vg2[DV == 128 ? 4 * (d & 1) + j : 0], o[DV == 128 ? d : 0], 0, 0, 0);
                    const float e0 = __builtin_amdgcn_exp2f(p1[2 * k]), e1 = __builtin_amdgcn_exp2f(p1[2 * k + 1]);
                    if (k > 0) { sa += f0; sa += f1; ATT_W(k - 1, cvtpk_m(f0, f1)); }
                    f0 = e0; f1 = e1;
                    __builtin_amdgcn_sched_barrier(0);
                }
                sa += f0; sa += f1; w7 = cvtpk_m(f0, f1);
                lsum += sa;
                { v4u q; q.x = w0; q.y = w1; q.z = w2; q.w = w3; pa2 = __builtin_bit_cast(bf16x8, q); q.x = w4; q.y = w5; q.z = w6; q.w = w7; pa3 = __builtin_bit_cast(bf16x8, q); }
#undef ATT_W
                __builtin_amdgcn_sched_barrier(0);
                { const LAS unsigned char* kn = lds + K_OFF + ((t + 1) & (NSLOT - 1)) * KSLOT;
#pragma unroll
                    for (int s = 0; s < 4; ++s) { kf[2 * s] = *(const LAS bf16x8*)(kn + xo[s]); kf[2 * s + 1] = *(const LAS bf16x8*)(kn + xo[s] + 4096); } }
                __builtin_amdgcn_sched_barrier(0);
#pragma unroll
                for (int k = 0; k < 8; ++k) {
                    const int j = (k >> 1) & 1, d = (k < 4 ? 2 : 0) + (k & 1);
                    o[DV == 128 ? d : 0] = __builtin_amdgcn_mfma_f32_32x32x16_bf16(j == 0 ? pa2 : pa3, d < 2 ? vf[4 * (d & 1) + 2 + j] : vg2[DV == 128 ? 4 * (d & 1) + 2 + j : 0], o[DV == 128 ? d : 0], 0, 0, 0);
                }
            } else {
            if (DV == 128) {
#pragma unroll
                for (int d0 = 0; d0 < 2; ++d0)
#pragma unroll
                    for (int j = 0; j < 4; ++j) o[DV == 128 ? 2 + d0 : d0] = __builtin_amdgcn_mfma_f32_32x32x16_bf16(j == 0 ? pa0 : j == 1 ? pa1 : j == 2 ? pa2 : pa3, vg2[DV == 128 ? 4 * d0 + j : 0], o[DV == 128 ? 2 + d0 : d0], 0, 0, 0);
            }
#pragma unroll
            for (int d0 = 0; d0 < 2; ++d0)
#pragma unroll
                for (int j = 0; j < 4; ++j) o[d0] = __builtin_amdgcn_mfma_f32_32x32x16_bf16(j == 0 ? pa0 : j == 1 ? pa1 : j == 2 ? pa2 : pa3, vf[4 * d0 + j], o[d0], 0, 0, 0);
            }
            __builtin_amdgcn_sched_barrier(0);
        }
        if (t + 3 < nt) asm volatile("s_waitcnt vmcnt(3) lgkmcnt(0)" ::: "memory");
        else asm volatile("s_waitcnt vmcnt(0) lgkmcnt(0)" ::: "memory");
        __builtin_amdgcn_s_barrier();
    }
#undef ATT_DMA
#undef ATT_SB
#undef ATT_VB
    { float gt;
      if (DV == 128) asm volatile("v_mov_b32 %0, %1\n\tv_mov_b32 %0, %2\n\tv_mov_b32 %0, %3\n\tv_mov_b32 %0, %4\n\ts_nop 1" : "=&v"(gt) : "v"(o[1][15]), "v"(o[0][15]), "v"(o[DV == 128 ? 3 : 1][15]), "v"(o[DV == 128 ? 2 : 0][15]));
      else asm volatile("v_mov_b32 %0, %1\n\tv_mov_b32 %0, %2\n\ts_nop 1" : "=&v"(gt) : "v"(o[1][15]), "v"(o[0][15]));
      asm volatile("" :: "v"(gt)); }
    lsum = swap_sum(lsum);
    if (hi == 0) wsf[r32] = __builtin_amdgcn_rcpf(lsum);
    LDS_WAIT();
#pragma unroll
    for (int r = 0; r < 16; ++r) { const float fr = wsf[crow(r, hi)];
#pragma unroll
        for (int d0 = 0; d0 < DV / 32; ++d0) o[d0][r] *= fr; }
    LDS_WAIT();
}
#define PA_SB() __builtin_amdgcn_sched_barrier(0)
#define PA_PIN(x) asm volatile("" : "+v"(x))
#define PA_KEEP(x) asm volatile("" :: "v"(x))
#define PA_MF(a, b, c) __builtin_amdgcn_mfma_f32_32x32x16_bf16(a, b, c, 0, 0, 0)
#define PA_MFMA_DONE(acc0, acc1) do { float t_; asm volatile("s_nop 15\n\tv_mov_b32 %0, %1\n\tv_mov_b32 %0, %2\n\ts_nop 1" : "=&v"(t_) : "v"(acc0[15]), "v"(acc1[15])); asm volatile("" :: "v"(t_)); } while (0)
template <bool MASKED>
__device__ __forceinline__ void attn_pass_p64(f32x16 (&o)[2], const bf16* Q, const bf16* K, const bf16* VT, const unsigned* MASKb, const LAS float* bias,
                                              int q0, int nt, LAS unsigned char* lds, int tid, int wave, int lane) {
    asm volatile("" : "+v"(tid), "+v"(lane));
    const int r32 = lane & 31, hi = lane >> 5, qw0 = q0 + 32 * wave, qpos = qw0 + r32;
    bf16x8 qf[4];
#pragma unroll
    for (int s = 0; s < 4; ++s) qf[s] = *(const bf16x8*)(Q + (size_t)qpos * 1024 + 16 * s + 8 * hi);
    const int srow = 8 * wave + (lane >> 3), spc = ((lane & 7) ^ ((srow >> 1) & 7)) * 8;
    unsigned koff = (unsigned)(srow * 1024 + spc) * 2u, voff = (unsigned)(srow * M + spc) * 2u, moff = (unsigned)qpos * 512u;
    const char* Ku = uni_ptr((const char*)K); const char* Vu = uni_ptr((const char*)VT); const char* Mu = MASKED ? uni_ptr((const char*)MASKb) : nullptr;
    LAS float* wsf = (LAS float*)(lds + WSF_OFF + wave * 256);
#define PA_DK(t) do { const char* b_ = Ku + (size_t)(t) * 131072; asm volatile("" : "+s"(b_)); asm volatile("" : "+v"(koff)); \
        __builtin_amdgcn_global_load_lds((const unsigned*)(b_ + koff), (LAS unsigned*)(lds + K_OFF + ((t) & 3) * KSLOT + wave * 1024), 16, 0, 0); } while (0)
#define PA_DV(t) do { const char* b_ = Vu + (size_t)(t) * 128; asm volatile("" : "+s"(b_)); asm volatile("" : "+v"(voff)); \
        __builtin_amdgcn_global_load_lds((const unsigned*)(b_ + voff), (LAS unsigned*)(lds + V_OFF + ((t) & 3) * VSLOT + wave * 1024), 16, 0, 0); } while (0)
#define PA_DM(t) do { if (MASKED) { const char* b_ = Mu + (size_t)(16 * ((t) >> 1)); asm volatile("" : "+s"(b_)); asm volatile("" : "+v"(moff)); \
        __builtin_amdgcn_global_load_lds((const unsigned*)(b_ + moff), (LAS unsigned*)(lds + MSK_OFF + wave * 4096 + ((t) & 3) * 1024), 16, 0, 0); } } while (0)
    constexpr int NOPS = MASKED ? 3 : 2;
    asm volatile("s_waitcnt lgkmcnt(0)\n\ts_barrier" ::: "memory");
    PA_DM(0); PA_DK(0); PA_DV(0); PA_DM(1); PA_DK(1); PA_DV(1); PA_DK(2);
    int xo[4];
#pragma unroll
    for (int s = 0; s < 4; ++s) xo[s] = r32 * 128 + (((2 * s + hi) ^ ((r32 >> 1) & 7)) * 16);
    asm volatile("s_waitcnt vmcnt(1)" ::: "memory");
    __builtin_amdgcn_s_barrier();
    bf16x8 kf[8], vf[8]; v4u pw0, pw1, pw2, pw3; f32x16 pA0, pA1, pB0, pB1;
    float lsum = 0.f; bool resc = false;
    f32x16 negm;
#pragma unroll
    for (int r = 0; r < 16; ++r) { o[0][r] = 0.f; o[1][r] = 0.f; negm[r] = 0.f; }
#define PA_KLD(s, tt) do { const LAS unsigned char* kn_ = lds + K_OFF + ((tt) & 3) * KSLOT; PA_KEEP(kf[2 * (s)]); PA_KEEP(kf[2 * (s) + 1]); kf[2 * (s)] = *(const LAS bf16x8*)(kn_ + xo[s]); kf[2 * (s) + 1] = *(const LAS bf16x8*)(kn_ + xo[s] + 4096); } while (0)
#define PA_BIAS(C0, C1, tt) do { const int kv0_ = 64 * (tt); if (kv0_ + 63 + 113 > qw0) { const int dq_ = qpos - kv0_ - 4 * hi + 1; \
        _Pragma("unroll") for (int r = 0; r < 16; ++r) { const int d_ = dq_ - ((r & 3) + 8 * (r >> 2)); C0[r] += bias[med3i(d_, 0, 128)]; C1[r] += bias[med3i(d_ - 32, 0, 128)]; } } } while (0)
#define PA_ROWMAX(rm, C0, C1) do { float a_ = max3f(C0[0], C0[1], C1[0]), b_ = max3f(C0[2], C0[3], C1[1]); a_ = max3f(a_, C1[2], C1[3]); \
        _Pragma("unroll") for (int r = 4; r < 16; r += 4) { a_ = max3f(a_, C0[r], C0[r + 1]); b_ = max3f(b_, C0[r + 2], C0[r + 3]); a_ = max3f(a_, C1[r], C1[r + 1]); b_ = max3f(b_, C1[r + 2], C1[r + 3]); } \
        rm = swap_max(max3f(a_, b_, b_)); } while (0)
#define PA_EXP4(X, i) do { X[i] = __builtin_amdgcn_exp2f(X[i]); X[(i) + 1] = __builtin_amdgcn_exp2f(X[(i) + 1]); X[(i) + 2] = __builtin_amdgcn_exp2f(X[(i) + 2]); X[(i) + 3] = __builtin_amdgcn_exp2f(X[(i) + 3]); PA_PIN(X); } while (0)
#pragma unroll
    for (int s = 0; s < 4; ++s) { kf[2 * s] = *(const LAS bf16x8*)(lds + K_OFF + xo[s]); kf[2 * s + 1] = *(const LAS bf16x8*)(lds + K_OFF + xo[s] + 4096); }
    PA_SB();
    { const f32x16 z16 = {0.f, 0.f, 0.f, 0.f, 0.f, 0.f, 0.f, 0.f, 0.f, 0.f, 0.f, 0.f, 0.f, 0.f, 0.f, 0.f};
#pragma unroll
      for (int s = 0; s < 4; ++s) { pA0 = PA_MF(kf[2 * s], qf[s], s == 0 ? z16 : pA0); pA1 = PA_MF(kf[2 * s + 1], qf[s], s == 0 ? z16 : pA1); } }
    PA_SB();
    PA_DM(2); PA_DV(2); PA_DK(3);
    PA_SB();
    asm volatile("s_nop 15\n\ts_nop 7" : "+v"(pA0), "+v"(pA1));
    PA_BIAS(pA0, pA1, 0);
    { float rm; PA_ROWMAX(rm, pA0, pA1); const float m0_ = (rm == -INFINITY) ? 0.f : rm;
#pragma unroll
      for (int r = 0; r < 16; ++r) { pA0[r] -= m0_; pA1[r] -= m0_; negm[r] = -m0_; } }
    PA_EXP4(pA0, 0); PA_EXP4(pA0, 4); PA_EXP4(pA0, 8); PA_EXP4(pA0, 12); PA_EXP4(pA1, 0); PA_EXP4(pA1, 4); PA_EXP4(pA1, 8); PA_EXP4(pA1, 12);
    PA_SB();
#pragma unroll
    for (int s = 0; s < 4; ++s) { const LAS unsigned char* kn_ = lds + K_OFF + KSLOT; PA_KEEP(kf[2 * s]); PA_KEEP(kf[2 * s + 1]); kf[2 * s] = *(const LAS bf16x8*)(kn_ + xo[s]); kf[2 * s + 1] = *(const LAS bf16x8*)(kn_ + xo[s] + 4096); }
    asm volatile("s_waitcnt vmcnt(%0) lgkmcnt(0)" :: "n"(NOPS) : "memory"); __builtin_amdgcn_s_barrier();
#define PA_C(r) (((r) & 3) + 8 * ((r) >> 2))
#define PA_FIN4(X, i, w, A, B) do { if (MASKED) { X[i] = __uint_as_float(__float_as_uint(X[i]) & bfe1(w, PA_C(i))); X[(i) + 1] = __uint_as_float(__float_as_uint(X[(i) + 1]) & bfe1(w, PA_C((i) + 1))); \
            X[(i) + 2] = __uint_as_float(__float_as_uint(X[(i) + 2]) & bfe1(w, PA_C((i) + 2))); X[(i) + 3] = __uint_as_float(__float_as_uint(X[(i) + 3]) & bfe1(w, PA_C((i) + 3))); } \
        sa_ = fadd_s(sa_, X[i]); sb_ = fadd_s(sb_, X[(i) + 1]); sa_ = fadd_s(sa_, X[(i) + 2]); sb_ = fadd_s(sb_, X[(i) + 3]); A = cvtpk(X[i], X[(i) + 1]); B = cvtpk(X[(i) + 2], X[(i) + 3]); } while (0)
#define PA_VLD(i, vb) do { PA_KEEP(vf[i]); vf[i] = *(const LAS bf16x8*)((vb) + xo[(i) & 3] + ((i) >> 2) * 4096); } while (0)
#define PA_GAPA(i, MFST, X, e, w, PW, A, B) do { PA_VLD(i, vb_); MFST; PA_KEEP(PW); PA_FIN4(X, e, w, PW.A, PW.B); PA_PIN(PW); PA_PIN(sa_); PA_PIN(sb_); PA_SB(); } while (0)
#define PA_MASKW(tt) u32x2 mw_ = {0u, 0u}; if (MASKED) mw_ = *(const LAS u32x2*)(lds + MSK_OFF + wave * 4096 + ((tt) & 3) * 1024 + r32 * 16 + ((tt) & 1) * 8); const unsigned w0_ = mw_.x >> (4 * hi), w1_ = mw_.y >> (4 * hi)
#define PA_PVB(j) __builtin_bit_cast(bf16x8, pw##j)
#define PA_STEP(C0, C1, P0, P1, tt) do { const int t_ = (tt); \
        { \
            const LAS unsigned char* vb_ = lds + V_OFF + ((t_ - 1) & 3) * VSLOT; PA_MASKW(t_ - 1); float sa_ = 0.f, sb_ = 0.f; \
            const f32x16 z16 = {0.f, 0.f, 0.f, 0.f, 0.f, 0.f, 0.f, 0.f, 0.f, 0.f, 0.f, 0.f, 0.f, 0.f, 0.f, 0.f}; \
            PA_SB(); \
            PA_GAPA(0, C0 = PA_MF(kf[0], qf[0], negm), P0, 0, w0_, pw0, x, y); \
            PA_GAPA(4, C1 = PA_MF(kf[1], qf[0], negm), P0, 4, w0_, pw0, z, w); \
            PA_GAPA(1, C0 = PA_MF(kf[2], qf[1], C0), P0, 8, w0_, pw1, x, y); \
            PA_GAPA(5, C1 = PA_MF(kf[3], qf[1], C1), P0, 12, w0_, pw1, z, w); \
            PA_GAPA(2, C0 = PA_MF(kf[4], qf[2], C0), P1, 0, w1_, pw2, x, y); \
            PA_GAPA(6, C1 = PA_MF(kf[5], qf[2], C1), P1, 4, w1_, pw2, z, w); \
            PA_GAPA(3, C0 = PA_MF(kf[6], qf[3], C0), P1, 8, w1_, pw3, x, y); \
            PA_GAPA(7, C1 = PA_MF(kf[7], qf[3], C1), P1, 12, w1_, pw3, z, w); \
            lsum += sa_ + sb_; \
            if (t_ + 2 < nt) { PA_DM(t_ + 2); PA_DV(t_ + 2); } if (t_ + 3 < nt) PA_DK(t_ + 3); \
            PA_SB(); \
            asm volatile("s_nop 3" : "+v"(C0), "+v"(C1));     \
            _Pragma("unroll") for (int i = 0; i < 8; ++i) PA_KEEP(kf[i]); _Pragma("unroll") for (int i = 0; i < 4; ++i) PA_KEEP(qf[i]);     \
            PA_BIAS(C0, C1, t_); \
            { float rm_; PA_ROWMAX(rm_, C0, C1); resc = false; \
              if (__any(rm_ > 8.f)) { const float dl_ = fmaxf(rm_, 0.f), f_ = __builtin_amdgcn_exp2f(-dl_); lsum *= f_; if (hi == 0) wsf[r32] = f_; resc = true; \
                  _Pragma("unroll") for (int r = 0; r < 16; ++r) { C0[r] -= dl_; C1[r] -= dl_; negm[r] -= dl_; } } } \
            PA_SB(); \
            o[0] = PA_MF(PA_PVB(0), vf[0], o[0]); PA_EXP4(C0, 0); PA_SB(); \
            o[1] = PA_MF(PA_PVB(0), vf[4], o[1]); PA_EXP4(C0, 4); PA_SB(); \
            if (t_ + 1 < nt) PA_KLD(0, t_ + 1); o[0] = PA_MF(PA_PVB(1), vf[1], o[0]); PA_EXP4(C0, 8); PA_SB(); \
            if (t_ + 1 < nt) PA_KLD(1, t_ + 1); o[1] = PA_MF(PA_PVB(1), vf[5], o[1]); PA_EXP4(C0, 12); PA_SB(); \
            if (t_ + 1 < nt) PA_KLD(2, t_ + 1); o[0] = PA_MF(PA_PVB(2), vf[2], o[0]); PA_EXP4(C1, 0); PA_SB(); \
            if (t_ + 1 < nt) PA_KLD(3, t_ + 1); o[1] = PA_MF(PA_PVB(2), vf[6], o[1]); PA_EXP4(C1, 4); PA_SB(); \
            o[0] = PA_MF(PA_PVB(3), vf[3], o[0]); PA_EXP4(C1, 8); PA_SB(); \
            o[1] = PA_MF(PA_PVB(3), vf[7], o[1]); PA_EXP4(C1, 12); PA_SB(); \
        } \
        if (t_ + 3 < nt) asm volatile("s_waitcnt vmcnt(%0) lgkmcnt(0)" :: "n"(NOPS) : "memory"); \
        else if (t_ + 2 < nt) asm volatile("s_waitcnt vmcnt(%0) lgkmcnt(0)" :: "n"(NOPS - 1) : "memory"); \
        else asm volatile("s_waitcnt vmcnt(0) lgkmcnt(0)" ::: "memory"); \
        __builtin_amdgcn_s_barrier(); \
        if (resc) { resc = false; _Pragma("unroll") for (int r = 0; r < 16; ++r) { const float fr_ = wsf[crow(r, hi)]; o[0][r] *= fr_; o[1][r] *= fr_; } LDS_WAIT(); } \
    } while (0)
#define PA_DRAIN(P0, P1, tt) do { const LAS unsigned char* vb_ = lds + V_OFF + ((tt) & 3) * VSLOT; PA_MASKW(tt); float sa_ = 0.f, sb_ = 0.f; \
        PA_MFMA_DONE(o[0], o[1]); PA_SB(); \
        _Pragma("unroll") for (int i = 0; i < 8; ++i) PA_VLD(i, vb_); \
        asm volatile("s_waitcnt lgkmcnt(0)\n\ts_barrier" : "+v"(vf[0]), "+v"(vf[1]), "+v"(vf[2]), "+v"(vf[3]), "+v"(vf[4]), "+v"(vf[5]), "+v"(vf[6]), "+v"(vf[7]) :: "memory");     \
        PA_KEEP(pw0); PA_KEEP(pw1); PA_KEEP(pw2); PA_KEEP(pw3); \
        PA_FIN4(P0, 0, w0_, pw0.x, pw0.y); PA_FIN4(P0, 4, w0_, pw0.z, pw0.w); PA_FIN4(P0, 8, w0_, pw1.x, pw1.y); PA_FIN4(P0, 12, w0_, pw1.z, pw1.w); \
        PA_FIN4(P1, 0, w1_, pw2.x, pw2.y); PA_FIN4(P1, 4, w1_, pw2.z, pw2.w); PA_FIN4(P1, 8, w1_, pw3.x, pw3.y); PA_FIN4(P1, 12, w1_, pw3.z, pw3.w); \
        lsum += sa_ + sb_; PA_SB(); \
        o[0] = PA_MF(PA_PVB(0), vf[0], o[0]); o[1] = PA_MF(PA_PVB(0), vf[4], o[1]); o[0] = PA_MF(PA_PVB(1), vf[1], o[0]); o[1] = PA_MF(PA_PVB(1), vf[5], o[1]); \
        o[0] = PA_MF(PA_PVB(2), vf[2], o[0]); o[1] = PA_MF(PA_PVB(2), vf[6], o[1]); o[0] = PA_MF(PA_PVB(3), vf[3], o[0]); o[1] = PA_MF(PA_PVB(3), vf[7], o[1]); PA_SB(); \
        PA_MFMA_DONE(o[0], o[1]); PA_SB();     \
        PA_KEEP(pw0); PA_KEEP(pw1); PA_KEEP(pw2); PA_KEEP(pw3); _Pragma("unroll") for (int i = 0; i < 8; ++i) PA_KEEP(vf[i]); } while (0)
    int t = 1;
    for (; t + 1 < nt; t += 2) { PA_STEP(pB0, pB1, pA0, pA1, t); PA_STEP(pA0, pA1, pB0, pB1, t + 1); }
    PA_STEP(pB0, pB1, pA0, pA1, nt - 1);
    PA_DRAIN(pB0, pB1, nt - 1);
#undef PA_DK
#undef PA_DV
#undef PA_DM
#undef PA_KLD
#undef PA_BIAS
#undef PA_ROWMAX
#undef PA_EXP4
#undef PA_C
#undef PA_FIN4
#undef PA_VLD
#undef PA_GAPA
#undef PA_MASKW
#undef PA_PVB
#undef PA_STEP
#undef PA_DRAIN
    lsum = swap_sum(lsum);
    if (hi == 0) wsf[r32] = __builtin_amdgcn_rcpf(lsum);
    LDS_WAIT();
#pragma unroll
    for (int r = 0; r < 16; ++r) { const float fr = wsf[crow(r, hi)]; o[0][r] *= fr; o[1][r] *= fr; }
    LDS_WAIT();
}
#undef PA_SB
#undef PA_PIN
#undef PA_KEEP
#undef PA_MF
template <int DV>
__device__ __forceinline__ void store_tile(const f32x16 (&o)[DV / 32], bf16* O, LAS unsigned char* lds, int wave, int lane) {
    asm volatile("" : "+v"(lane));
    const int r32 = lane & 31, hi = lane >> 5;
    LAS bf16* stg = (LAS bf16*)(lds + OST_OFF + wave * 8192);
#pragma unroll
    for (int d0 = 0; d0 < DV / 32; ++d0)
#pragma unroll
        for (int r = 0; r < 16; ++r) stg[crow(r, hi) * DV + 32 * d0 + r32] = (bf16)f2bf(o[d0][r]);
    LDS_WAIT();
    constexpr int CPR = DV / 8;
#pragma unroll
    for (int i = 0; i < 32 * CPR / 64; ++i) { const int id = i * 64 + lane, row = id / CPR, ch = id % CPR;
        const v4u v = *(const LAS v4u*)(stg + row * DV + ch * 8); *(v4u*)(O + (size_t)row * 1024 + ch * 8) = v; }
    LDS_WAIT();
}
}

__device__ __forceinline__ void dsa_unit(const Ptrs& P, const LAS float* biasT, int b, int h, int qb, LAS unsigned char* lds, int tid, int wave, int lane) {
    asm volatile("" : "+v"(lane));
    const int q0 = 256 * qb, qpos = q0 + 32 * wave + (lane & 31);
    att::f32x16 o[2];
    att::attn_pass_p64<true>(o, P.QO + (size_t)b * SEQ * 1024 + h * 64, P.KK + (size_t)b * SEQ * 1024 + h * 64, P.VT + (size_t)(h * 64) * M + (size_t)b * SEQ,
                             P.MASK + (size_t)(b * SEQ) * 128, biasT + h * BIAS_LD, q0, 4 * (qb + 1), lds, tid, wave, lane);
    att::store_tile<64>(o, P.MIX + (size_t)(b * SEQ + q0 + 32 * wave) * 1024 + h * 64, lds, wave, lane);
}
__device__ __forceinline__ void diff_unit(const Ptrs& P, const LAS float* biasT, const float* subln, float lam_full, float lam_init, int b, int hd, int qb, LAS unsigned char* lds, int tid, int wave, int lane) {
    asm volatile("" : "+v"(lane));
    const int q0 = 256 * qb, r32 = lane & 31;
    const bf16* Qb = P.QO + (size_t)b * SEQ * 1024 + 512 + hd * 128; const bf16* Kb = P.KK + (size_t)b * SEQ * 1024 + 512 + hd * 128; const bf16* Vb = P.VT + (size_t)(512 + hd * 128) * M + (size_t)b * SEQ;
    att::f32x16 o[4];
    att::attn_pass<128, false>(o, Qb, Kb, Vb, nullptr, biasT + (8 + hd) * BIAS_LD, q0, 4 * (qb + 1), lds, tid, wave, lane);
    bf16* Ow = P.MIX + (size_t)(b * SEQ + q0 + 32 * wave) * 1024 + 512 + hd * 128;
    att::store_tile<128>(o, Ow, lds, wave, lane);
    att::attn_pass<128, false>(o, Qb + 64, Kb + 64, Vb, nullptr, biasT + (8 + hd) * BIAS_LD, q0, 4 * (qb + 1), lds, tid, wave, lane);
    LAS bf16* stg = (LAS bf16*)(lds + att::OST_OFF + wave * 8192);
    asm volatile("s_waitcnt vmcnt(0)" ::: "memory");
    { v4u pk[8];
#pragma unroll
      for (int i = 0; i < 8; ++i) { const int id = i * 64 + lane, row = id >> 4, ch = id & 15; pk[i] = *(const v4u*)(Ow + (size_t)row * 1024 + ch * 8); }
      asm volatile("s_waitcnt vmcnt(0)" ::: "memory");
#pragma unroll
      for (int i = 0; i < 8; ++i) { const int id = i * 64 + lane, row = id >> 4, ch = id & 15; *(LAS v4u*)(stg + row * 128 + ch * 8) = pk[i]; } }
    LDS_WAIT();
    float ss[16];
    { const int hi = lane >> 5;
#pragma unroll
      for (int r = 0; r < 16; ++r) { float s = 0.f;
#pragma unroll
        for (int d0 = 0; d0 < 4; ++d0) { const float d = bf2f(stg[att::crow(r, hi) * 128 + 32 * d0 + r32]) - lam_full * o[d0][r]; o[d0][r] = d; s += d * d; }
        ss[r] = s; } }
    LDS_WAIT();
    float g[4];
#pragma unroll
    for (int d0 = 0; d0 < 4; ++d0) g[d0] = subln[32 * d0 + r32] * (1.f - lam_init);
#pragma unroll
    for (int r = 0; r < 16; ++r) { float s = ss[r];
#pragma unroll
        for (int m = 1; m < 32; m <<= 1) s += __shfl_xor(s, m);
        const float rn = __builtin_amdgcn_rsqf(s * (1.f / 128.f) + 1e-6f);
#pragma unroll
        for (int d0 = 0; d0 < 4; ++d0) o[d0][r] *= rn * g[d0]; }
    att::store_tile<128>(o, P.MIX + (size_t)(b * SEQ + q0 + 32 * wave) * 1024 + 512 + hd * 128, lds, wave, lane);
}
__device__ __forceinline__ void attn_phase(const Ptrs& P, const LAS float* biasT, const float* subln, float lam_full, float lam_init, LAS unsigned char* lds, int bid, int G, int tid, int wave, int lane) {
    for (int vb = bid; vb < 256; vb += G) {
        const int vcu = (vb & 7) * 32 + (vb >> 3), g = vcu >> 2, k = vcu & 3;
        for (int j = 0; j < 2; ++j) { const int bh = 2 * g + j;
            for (int i = 0; i < 4; ++i) { const int qb = (i == 0) ? 15 - k : (i == 1) ? k : (i == 2) ? 11 - k : 4 + k; dsa_unit(P, biasT, bh >> 3, bh & 7, qb, lds, tid, wave, lane); } }
        for (int i = 0; i < 4; ++i) { const int qb = (i == 0) ? 15 - k : (i == 1) ? k : (i == 2) ? 11 - k : 4 + k; diff_unit(P, biasT, subln, lam_full, lam_init, g >> 2, g & 3, qb, lds, tid, wave, lane); }
    }
}

struct Args { const float* in[12]; float* out; unsigned char* ws; int ph_lo, ph_hi; };
__global__ void __launch_bounds__(NWAVES * 64, 2) fwd_kernel(Args args) {
    extern __shared__ __attribute__((aligned(16))) unsigned char lds_raw[];
    LAS unsigned char* lds = (LAS unsigned char*)lds_raw;
    volatile LAS unsigned* MISC = (volatile LAS unsigned*)(lds + MISC_OFF);
    const int tid = threadIdx.x;
#define ENTER() int tidl_ = threadIdx.x; asm volatile("" : "+v"(tidl_)); int bid_ = blockIdx.x, G = gridDim.x; asm volatile("" : "+s"(bid_), "+s"(G)); \
    const int lane = tidl_ & 63, wave = __builtin_amdgcn_readfirstlane(tidl_ >> 6), gw = bid_ * NWAVES + wave, NGW = G * NWAVES; (void)lane; (void)gw; (void)NGW; \
    LAS float* sc = (LAS float*)(lds + RING_OFF + wave * 16384); LAS float* qs = (LAS float*)(lds + WSCR_OFF + wave * 2048); const LAS float* biasT = (const LAS float*)(lds + BIAS_OFF); (void)sc; (void)qs; (void)biasT;
    typedef const __attribute__((address_space(4))) Args* KArgs;
    KArgs kargs = (KArgs)__builtin_amdgcn_kernarg_segment_ptr();
#define MKP() Ptrs P; { KArgs ka_ = kargs; asm volatile("" : "+s"(ka_)); unsigned char* ws = ka_->ws; \
    P.x = ka_->in[0]; P.attn_norm = ka_->in[1]; P.w_in = ka_->in[2]; P.diff_lambda = ka_->in[3]; P.diff_subln = ka_->in[4]; P.w_out = ka_->in[5]; P.ffn_norm = ka_->in[6]; \
    P.w_gate = ka_->in[7]; P.w_up = ka_->in[8]; P.w_down = ka_->in[9]; P.rel_bias = ka_->in[10]; P.final_norm = ka_->in[11]; P.out = ka_->out; \
    P.WIN = (bf16*)(ws + WS_WIN); P.WOUT = (bf16*)(ws + WS_WOUT); P.WGU = (bf16*)(ws + WS_WGU); P.WDN = (bf16*)(ws + WS_WDN); P.IK = (bf16*)(ws + WS_IK); \
    P.XB = (bf16*)(ws + WS_XB); P.QO = (bf16*)(ws + WS_QO); P.KK = (bf16*)(ws + WS_KK); P.VT = (bf16*)(ws + WS_VT); P.IQ = (bf16*)(ws + WS_IQ); P.ACT = (bf16*)(ws + WS_ACT); P.MIX = (bf16*)(ws + WS_MIX); \
    P.SS = (float*)(ws + WS_SS); P.IW = (float*)(ws + WS_IW); P.MASK = (unsigned*)(ws + WS_MASK); }
    gu32* ctl = (gu32*)(kargs->ws + WS_CTL);
    for (int u = tid; u < (LDS_BYTES - MISC_OFF) / 4; u += NWAVES * 64) ((LAS unsigned*)(lds + MISC_OFF))[u] = 0u;
    { MKP(); ENTER(); LAS float* bt = (LAS float*)(lds + BIAS_OFF);
      for (int i = tid; i < 12 * BIAS_LD; i += NWAVES * 64) { const int h = i / BIAS_LD, e = i % BIAS_LD; float v = 0.f;
          if (e == 0) v = -INFINITY; else if (e <= 128) v = (P.rel_bias[(int)T5_BUCKET[e - 1] * 12 + h] - P.rel_bias[31 * 12 + h]) * 1.4426950408889634f;
          bt[i] = v; } }
    __syncthreads();
    XcdBarrier bar; bar.bar = (unsigned*)(ctl + CW_BAR); bar.x = 0; bar.st = nullptr;
    if (!MK_PER_PHASE) bar = xcd_barrier_post((unsigned*)(ctl + CW_BAR), MISC + 8);
    const int lo = kargs->ph_lo, hi = kargs->ph_hi;
#define IN(k) (lo <= (k) && (k) < hi)
#define SEAM(k) do { if (IN(k) && IN((k) + 1)) xcd_barrier(bar); } while (0)

    if (IN(0)) { MKP(); ENTER(); prologue(P, lds, gw, NGW, wave, lane); }
    SEAM(0);
    for (int l = 0; l < DEPTH; ++l) {
        const int p0 = 1 + 6 * l;
        if (IN(p0)) {
            MKP(); ENTER();
            { pg8::Gemm g{P.XB, P.WIN + (size_t)l * NIN * DM, M, NIN_MAIN, DM}; pg8::StaticOrder S; S.init(M, NIN_MAIN, G, bid_);
              pg8::EpiInProj E{P.QO, P.KK, P.IQ, P.IK, P.IW, P.SS};
              pg8::gemm_phase<pg8::EpiInProj, pg8::StaticOrder, true, true>(lds + RING_OFF, g, S, E); }
            { pg8::Gemm g{P.WIN + ((size_t)l * NIN + NIN_MAIN) * DM, P.XB, NIN_V, M, DM}; pg8::StaticOrder S; S.init(NIN_V, M, G, bid_);
              pg8::EpiVT E{P.VT, P.SS};
              pg8::gemm_phase<pg8::EpiVT, pg8::StaticOrder, true, true>(lds + RING_OFF, g, S, E); }
        }
        SEAM(p0);
        if (IN(p0 + 1)) {
            MKP(); ENTER();
            idx::idx_phase<0>(P, lds, bid_, G, tidl_, wave, lane);
            if (PROBE_IDX > 1) idx::idx_phase<PROBE_IDX - 1>(P, lds, bid_, G, tidl_, wave, lane);
        }
        SEAM(p0 + 1);
        if (IN(p0 + 2)) {
            MKP(); ENTER();
            const float lam_init = 0.8f - 0.6f * __expf(-0.3f * (float)l);
            const float* lam = P.diff_lambda + l * 256;
            const float lam_full = __expf(wave_sum(lam[lane] * lam[64 + lane])) - __expf(wave_sum(lam[128 + lane] * lam[192 + lane])) + lam_init;
            for (int rep = 0; rep < PROBE_ATT; ++rep) attn_phase(P, biasT, P.diff_subln + l * 128, lam_full, lam_init, lds, bid_, G, tidl_, wave, lane);
        }
        SEAM(p0 + 2);
        if (IN(p0 + 3)) {
            MKP(); ENTER();
            pg8::Gemm g{P.MIX, P.WOUT + (size_t)l * DM * DM, M, DM, DM}; pg8::StaticOrder S; S.init(M, DM, G, bid_);
            pg8::EpiRes E{l == 0 ? P.x : nullptr, P.XB, P.SS};
            pg8::gemm_phase<pg8::EpiRes, pg8::StaticOrder, true, true>(lds + RING_OFF, g, S, E);
        }
        SEAM(p0 + 3);
        if (IN(p0 + 4)) {
            MKP(); ENTER();
            pg8::Gemm g{P.XB, P.WGU + (size_t)l * NGU * DM, M, NGU, DM}; pg8::StaticOrder S; S.init(M, NGU, G, bid_);
            pg8::EpiGateUp E{P.ACT, P.SS};
            for (int rep = 0; rep < PROBE_GU; ++rep) pg8::gemm_phase<pg8::EpiGateUp, pg8::StaticOrder, true, true>(lds + RING_OFF, g, S, E);
        }
        SEAM(p0 + 4);
        if (IN(p0 + 5)) {
            MKP(); ENTER();
            pg8::Gemm g{P.ACT, P.WDN + (size_t)l * DM * DFF, M, DM, DFF}; pg8::StaticOrder S; S.init(M, DM, G, bid_);
            pg8::EpiRes E{nullptr, P.XB, P.SS};
            pg8::gemm_phase<pg8::EpiRes, pg8::StaticOrder, true, true>(lds + RING_OFF, g, S, E);
        }
        SEAM(p0 + 5);
    }
    if (IN(NPH - 1)) { MKP(); ENTER(); final_norm_phase(P, gw, NGW, lane); }
#undef IN
#undef MKP
#undef ENTER
#undef SEAM
}

extern "C" void kernel_launch(void* const* d_in, const int* in_sizes, int n_in, void* d_out, int out_size, void* d_ws, size_t ws_size, hipStream_t stream) {
    static int grid = 0;
    if (grid == 0) {
        if (n_in != 12 || in_sizes[0] != M * DM || out_size != M * DM || ws_size < WS_END) { fprintf(stderr, "kernel_launch: unexpected shapes (n_in %d, in0 %d, out %d, ws %zu); nothing launched\n", n_in, n_in > 0 ? in_sizes[0] : -1, out_size, ws_size); grid = -1; return; }
        int dev = 0, cus = 0, per_cu = 0;
        if (hipGetDevice(&dev) != hipSuccess || hipDeviceGetAttribute(&cus, hipDeviceAttributeMultiprocessorCount, dev) != hipSuccess) { grid = -1; return; }
        if (hipFuncSetAttribute((const void*)fwd_kernel, hipFuncAttributeMaxDynamicSharedMemorySize, LDS_BYTES) != hipSuccess) { fprintf(stderr, "kernel_launch: hipFuncSetAttribute failed\n"); grid = -1; return; }
        if (hipOccupancyMaxActiveBlocksPerMultiprocessor(&per_cu, (const void*)fwd_kernel, NWAVES * 64, LDS_BYTES) != hipSuccess || per_cu < 1)
            fprintf(stderr, "kernel_launch: note: occupancy query reports %d workgroups per CU\n", per_cu);
        (void)hipGetLastError();
        grid = cus;
    }
    if (grid < 0) return;
    if (hipMemsetAsync((char*)d_ws + WS_CTL, 0, CTL_ZERO_BYTES, stream) != hipSuccess) return;
    Args a{};
    for (int i = 0; i < 12; ++i) a.in[i] = (const float*)d_in[i];
    a.out = (float*)d_out; a.ws = (unsigned char*)d_ws;
#if MK_PER_PHASE
    for (int k = 0; k < NPH; ++k) { a.ph_lo = k; a.ph_hi = k + 1; hipLaunchKernelGGL(fwd_kernel, dim3(grid), dim3(NWAVES * 64), LDS_BYTES, stream, a); }
#else
    a.ph_lo = 0; a.ph_hi = NPH;
    hipLaunchKernelGGL(fwd_kernel, dim3(grid), dim3(NWAVES * 64), LDS_BYTES, stream, a);
#endif
    const hipError_t le = hipPeekAtLastError();
    if (le != hipSuccess) fprintf(stderr, "kernel_launch: launch failed: %s\n", hipGetErrorName(le));
}
```

```cpp
#include <hip/hip_runtime.h>
#include <cstdio>
#include <cstdint>
namespace pg8 {
#define PG8_LAS __attribute__((address_space(3)))
typedef unsigned short bf16_t;
typedef short bf16x8 __attribute__((ext_vector_type(8)));
typedef float f32x4 __attribute__((ext_vector_type(4)));
typedef unsigned u32x4 __attribute__((ext_vector_type(4)));
constexpr int BM = 256, BK = 64, HALF = 128, HTB = HALF * BK * 2  , STAGE_BYTES = 8 * HTB, NXCD = 8, WGM = 8;

__host__ __device__ __forceinline__ int lds_byte(int r, int c) { const int st = (r >> 4) * 2 + (c >> 5), rr = r & 15, cc = c & 31, ob = rr * 64 + cc * 2; return st * 1024 + (ob ^ (((ob >> 9) & 1) << 5)); }
__host__ __device__ __forceinline__ void stage_rc(int b, int& R, int& C) { const int st = b / 1024, sb = b % 1024, swz = sb ^ (((sb >> 9) & 1) << 5); R = (st >> 1) * 16 + swz / 64; C = (st & 1) * 32 + (swz % 64) / 2; }
__host__ __device__ __forceinline__ int perm32(int rho) { const int n = rho >> 4, i = rho & 15; return 8 * (i >> 2) + 4 * n + (i & 3); }

struct Unit { int pm, pn; };
struct Gemm { const bf16_t* A; const bf16_t* Bt; int M, N, K; };

struct StaticOrder {
    int nM, nN, nwg, G, c;
    __host__ __device__ void init(int M, int N, int G_, int c_) { nM = M / BM; nN = N / BM; nwg = nM * nN; G = G_; c = c_; }
    __host__ __device__ bool next(int i, Unit& u) const {
        const long L = (long)i * G + c; if (L >= nwg) return false;
        int wgid = (int)L; { const int q = nwg / NXCD, r = nwg % NXCD, xcd = wgid % NXCD, off = wgid / NXCD; wgid = (xcd < r ? xcd * (q + 1) : r * (q + 1) + (xcd - r) * q) + off; }
        const int nig = WGM * nN, gid = wgid / nig, fm = gid * WGM, gsz = (nM - fm) < WGM ? (nM - fm) : WGM;
        u.pm = fm + ((wgid % nig) % gsz); u.pn = (wgid % nig) / gsz; return true;
    }
    __device__ __forceinline__ void a_ready(const Unit&) const {}
    __device__ __forceinline__ void done(const Unit&) const {}
};

__device__ __forceinline__ unsigned cvt_pk_bf16(float lo, float hi) { unsigned r; asm volatile("v_cvt_pk_bf16_f32 %0, %1, %2" : "=v"(r) : "v"(lo), "v"(hi)); return r; }
typedef float f32x2 __attribute__((ext_vector_type(2)));
typedef float f32x2 __attribute__((ext_vector_type(2)));
typedef unsigned u32x2v __attribute__((ext_vector_type(2)));
constexpr float RMS_EPS = 1e-6f;
constexpr float QSCALE = 0.125f * 1.4426950408889634f;
__device__ __forceinline__ float row_rs(const float* SS, int row) {
    const f32x4* p = (const f32x4*)(SS + (size_t)row * 16); const f32x4 a = p[0], b = p[1], c = p[2], d = p[3];
    const float s = ((a[0] + a[1]) + (a[2] + a[3])) + ((b[0] + b[1]) + (b[2] + b[3])) + ((c[0] + c[1]) + (c[2] + c[3])) + ((d[0] + d[1]) + (d[2] + d[3]));
    return __builtin_amdgcn_rsqf(s * (1.f / 1024.f) + RMS_EPS);
}
constexpr int RS_LDS_OFF = 131072;
__device__ __forceinline__ const PG8_LAS float* stage_rs(const float* SS, int row0) {
    PG8_LAS float* rb = (PG8_LAS float*)(uintptr_t)RS_LDS_OFF;
    int tid = threadIdx.x; asm volatile("" : "+v"(tid));
    if (tid < 256) rb[tid] = row_rs(SS, row0 + tid);
    asm volatile("s_waitcnt lgkmcnt(0)\n\ts_barrier" ::: "memory");
    return rb;
}
struct EpiInProj {
    static constexpr bool PERM = true, AFTER_DRAIN = false;
    bf16_t *QO, *KK, *IQ, *IK; float* IW; const float* SS;
    __device__ __forceinline__ void operator()(const f32x4 (&acc)[2][2][4][2], const Unit& u, int wr, int wc, int fr, int fq) const {
        const int row0 = u.pm * BM + wr * 64 + fr, pn = u.pn, lr0 = wr * 64 + fr;
        const PG8_LAS float* rb = stage_rs(SS, u.pm * BM);
        if (pn < 10) {
            bf16_t* base; int ldc, colt; float sc = 1.f;
            if (pn < 4) { base = QO; ldc = 1024; colt = pn * 256; sc = QSCALE; }
            else if (pn < 8) { base = KK; ldc = 1024; colt = (pn - 4) * 256; }
            else { base = IQ; ldc = 512; colt = (pn - 8) * 256; }
            const int col0 = colt + wc * 32 + 8 * fq;
#pragma unroll
            for (int ai = 0; ai < 2; ++ai)
#pragma unroll
                for (int m = 0; m < 4; ++m) { bf16_t* rowp = base + (size_t)(row0 + ai * HALF + m * 16) * ldc + col0; const float s = rb[lr0 + ai * HALF + m * 16] * sc;
#pragma unroll
                    for (int bj = 0; bj < 2; ++bj) { const f32x4 v0 = acc[ai][bj][m][0] * s, v1 = acc[ai][bj][m][1] * s;
                        u32x4 w; w.x = cvt_pk_bf16(v0[0], v0[1]); w.y = cvt_pk_bf16(v0[2], v0[3]); w.z = cvt_pk_bf16(v1[0], v1[1]); w.w = cvt_pk_bf16(v1[2], v1[3]);
                        *(u32x4*)(rowp + bj * HALF) = w; }
                    }
        } else {
            const int c = wc * 32 + 8 * fq;
#pragma unroll
            for (int ai = 0; ai < 2; ++ai)
#pragma unroll
                for (int m = 0; m < 4; ++m) { const int row = row0 + ai * HALF + m * 16; const float s = rb[lr0 + ai * HALF + m * 16];
                    const f32x4 v0 = acc[ai][0][m][0] * s, v1 = acc[ai][0][m][1] * s;
                    if (c < 64) { u32x4 w; w.x = cvt_pk_bf16(v0[0], v0[1]); w.y = cvt_pk_bf16(v0[2], v0[3]); w.z = cvt_pk_bf16(v1[0], v1[1]); w.w = cvt_pk_bf16(v1[2], v1[3]);
                        *(u32x4*)(IK + (size_t)row * 64 + c) = w; }
                    else if (c == 64) { *(f32x4*)(IW + (size_t)row * 8) = v0; *(f32x4*)(IW + (size_t)row * 8 + 4) = v1; }
                    }
        }
    }
};
struct EpiVT {
    static constexpr bool PERM = true, AFTER_DRAIN = false;
    bf16_t* VT; const float* SS;
    __device__ __forceinline__ void operator()(const f32x4 (&acc)[2][2][4][2], const Unit& u, int wr, int wc, int fr, int fq) const {
        const int row0 = u.pm * BM + wr * 64 + fr, col0 = u.pn * BM + wc * 32 + 8 * fq;
        const PG8_LAS float* rb = stage_rs(SS, u.pn * BM);
        const int pos0 = (col0 & ~15) + ((col0 & 8) ? 4 : 0);
#pragma unroll
        for (int bj = 0; bj < 2; ++bj) { float rs[8];
#pragma unroll
            for (int i = 0; i < 8; ++i) rs[i] = rb[wc * 32 + 8 * fq + bj * HALF + i];
#pragma unroll
            for (int ai = 0; ai < 2; ++ai)
#pragma unroll
                for (int m = 0; m < 4; ++m) { const f32x4 v0 = acc[ai][bj][m][0], v1 = acc[ai][bj][m][1];
                    u32x2v w0, w1; w0.x = cvt_pk_bf16(v0[0] * rs[0], v0[1] * rs[1]); w0.y = cvt_pk_bf16(v0[2] * rs[2], v0[3] * rs[3]); w1.x = cvt_pk_bf16(v1[0] * rs[4], v1[1] * rs[5]); w1.y = cvt_pk_bf16(v1[2] * rs[6], v1[3] * rs[7]);
                    bf16_t* p = VT + (size_t)(row0 + ai * HALF + m * 16) * 65536 + pos0 + bj * HALF;
                    *(u32x2v*)p = w0; *(u32x2v*)(p + 8) = w1; }
            }
    }
};
struct EpiRes {
    static constexpr bool PERM = true, AFTER_DRAIN = false;
    const float* Xf32; bf16_t* XB; float* SS;
    __device__ __forceinline__ void operator()(const f32x4 (&acc)[2][2][4][2], const Unit& u, int wr, int wc, int fr, int fq) const {
        const int row0 = u.pm * BM + wr * 64 + fr, col0 = u.pn * BM + wc * 32 + 8 * fq;
        if (Xf32) {
#pragma unroll
            for (int ai = 0; ai < 2; ++ai)
#pragma unroll
                for (int m = 0; m < 4; ++m) { const int row = row0 + ai * HALF + m * 16; const size_t off = (size_t)row * 1024 + col0; float ss = 0.f;
#pragma unroll
                    for (int bj = 0; bj < 2; ++bj) { const f32x4 x0 = *(const f32x4*)(Xf32 + off + bj * HALF), x1 = *(const f32x4*)(Xf32 + off + bj * HALF + 4);
                        const f32x4 v0 = acc[ai][bj][m][0] + x0, v1 = acc[ai][bj][m][1] + x1;
                        u32x4 w; w.x = cvt_pk_bf16(v0[0], v0[1]); w.y = cvt_pk_bf16(v0[2], v0[3]); w.z = cvt_pk_bf16(v1[0], v1[1]); w.w = cvt_pk_bf16(v1[2], v1[3]);
                        *(u32x4*)(XB + off + bj * HALF) = w;
                        ss += (v0[0] * v0[0] + v0[1] * v0[1]) + (v0[2] * v0[2] + v0[3] * v0[3]) + (v1[0] * v1[0] + v1[1] * v1[1]) + (v1[2] * v1[2] + v1[3] * v1[3]); }
                    ss += __shfl_xor(ss, 16); ss += __shfl_xor(ss, 32);
                    if (fq == 0) SS[(size_t)row * 16 + u.pn * 4 + wc] = ss;
                    asm volatile("" ::: "memory"); }
            return;
        }
#pragma unroll
        for (int ai = 0; ai < 2; ++ai) { u32x4 xb[4][2];
#pragma unroll
            for (int m = 0; m < 4; ++m)
#pragma unroll
                for (int bj = 0; bj < 2; ++bj) xb[m][bj] = *(const u32x4*)(XB + (size_t)(row0 + ai * HALF + m * 16) * 1024 + col0 + bj * HALF);
#pragma unroll
            for (int m = 0; m < 4; ++m) { const int row = row0 + ai * HALF + m * 16; const size_t off = (size_t)row * 1024 + col0; float ss = 0.f;
#pragma unroll
                for (int bj = 0; bj < 2; ++bj) { const u32x4 x = xb[m][bj];
                    const f32x4 x0 = (f32x4){__builtin_bit_cast(float, x.x << 16), __builtin_bit_cast(float, x.x & 0xffff0000u), __builtin_bit_cast(float, x.y << 16), __builtin_bit_cast(float, x.y & 0xffff0000u)};
                    const f32x4 x1 = (f32x4){__builtin_bit_cast(float, x.z << 16), __builtin_bit_cast(float, x.z & 0xffff0000u), __builtin_bit_cast(float, x.w << 16), __builtin_bit_cast(float, x.w & 0xffff0000u)};
                    const f32x4 v0 = acc[ai][bj][m][0] + x0, v1 = acc[ai][bj][m][1] + x1;
                    u32x4 w; w.x = cvt_pk_bf16(v0[0], v0[1]); w.y = cvt_pk_bf16(v0[2], v0[3]); w.z = cvt_pk_bf16(v1[0], v1[1]); w.w = cvt_pk_bf16(v1[2], v1[3]);
                    *(u32x4*)(XB + off + bj * HALF) = w;
                    ss += (v0[0] * v0[0] + v0[1] * v0[1]) + (v0[2] * v0[2] + v0[3] * v0[3]) + (v1[0] * v1[0] + v1[1] * v1[1]) + (v1[2] * v1[2] + v1[3] * v1[3]); }
                ss += __shfl_xor(ss, 16); ss += __shfl_xor(ss, 32);
                if (fq == 0) SS[(size_t)row * 16 + u.pn * 4 + wc] = ss; }
            asm volatile("" ::: "memory"); }
    }
};
struct EpiGateUp {
    static constexpr bool PERM = true, AFTER_DRAIN = false;
    bf16_t* ACT; const float* SS;
    __device__ __forceinline__ void operator()(const f32x4 (&acc)[2][2][4][2], const Unit& u, int wr, int wc, int fr, int fq) const {
        const int row0 = u.pm * BM + wr * 64 + fr, col0 = u.pn * HALF + wc * 32 + 8 * fq;
        const PG8_LAS float* rb = stage_rs(SS, u.pm * BM);
#pragma unroll
        for (int ai = 0; ai < 2; ++ai)
#pragma unroll
            for (int m = 0; m < 4; ++m) { const int row = row0 + ai * HALF + m * 16; const float s = rb[wr * 64 + fr + ai * HALF + m * 16];
                float a[8];
#pragma unroll
                for (int n = 0; n < 2; ++n)
#pragma unroll
                    for (int i = 0; i < 4; ++i) { const float g = acc[ai][0][m][n][i] * s, up = acc[ai][1][m][n][i] * s;
                        a[4 * n + i] = g * __builtin_amdgcn_rcpf(1.f + __builtin_amdgcn_exp2f(-1.4426950408889634f * g)) * up; }
                u32x4 w; w.x = cvt_pk_bf16(a[0], a[1]); w.y = cvt_pk_bf16(a[2], a[3]); w.z = cvt_pk_bf16(a[4], a[5]); w.w = cvt_pk_bf16(a[6], a[7]);
                *(u32x4*)(ACT + (size_t)row * 2816 + col0) = w; }
    }
};

template <class Epi, class Sched, bool ALIGN_EPI = false, bool SP2 = false>
__device__ __forceinline__ void gemm_phase(PG8_LAS unsigned char* lds, const Gemm g, const Sched& S, const Epi& E) {
    int tid_l = threadIdx.x; asm volatile("" : "+v"(tid_l));
    const int tid = tid_l, wid = __builtin_amdgcn_readfirstlane(tid >> 6), lane = tid & 63, wr = wid >> 2, wc = wid & 3, fr = lane & 15, fq = lane >> 4;
    const int K = g.K, nt = K / BK;
    unsigned voffA[2], voffB[2];
#pragma unroll
    for (int i = 0; i < 2; ++i) { int R, C; stage_rc(tid * 16 + i * 8192, R, C); const int Rb = Epi::PERM ? ((R & ~31) + perm32(R & 31)) : R;
        voffA[i] = (unsigned)(R * K + C) * 2u; voffB[i] = (unsigned)(Rb * K + C) * 2u; }
    const size_t kstep = (size_t)(BK * 2);
    const size_t hstep = (size_t)HALF * K * 2;
    const size_t tstep = 2 * hstep;
    const unsigned ldsw = (unsigned)wid * 1024u;
    const int aoff = lds_byte(wr * 64 + fr, fq * 8), boff = lds_byte(wc * 32 + fr, fq * 8);
#define PG8_SA(b, h) (((b) * 2 + (h)) * HTB)
#define PG8_SB(b, h) ((4 + (b) * 2 + (h)) * HTB)
#define PG8_STAGE(bufoff, gbase, voff) do { const char* gb_ = (const char*)(gbase); asm volatile("" : "+s"(gb_)); _Pragma("unroll") for (int _i = 0; _i < 2; ++_i) { asm volatile("" : "+v"((voff)[_i])); \
        __builtin_amdgcn_global_load_lds((const unsigned*)(gb_ + (voff)[_i]), (PG8_LAS unsigned*)(lds + (bufoff) + ldsw + _i * 8192), 16, 0, 0); } } while (0)
#define PG8_LDA(dst, b, h) do { _Pragma("unroll") for (int m = 0; m < 4; ++m) _Pragma("unroll") for (int k = 0; k < 2; ++k) dst[m][k] = *(const PG8_LAS bf16x8*)(lds + PG8_SA(b, h) + aoff + m * 2048 + k * 1024); } while (0)
#define PG8_LDB(dst, b, h) do { _Pragma("unroll") for (int n = 0; n < 2; ++n) _Pragma("unroll") for (int k = 0; k < 2; ++k) dst[n][k] = *(const PG8_LAS bf16x8*)(lds + PG8_SB(b, h) + boff + n * 2048 + k * 1024); } while (0)
#define PG8_MMA(ai, bj, At, Bt) do { __builtin_amdgcn_s_setprio(1); _Pragma("unroll") for (int m = 0; m < 4; ++m) _Pragma("unroll") for (int n = 0; n < 2; ++n) _Pragma("unroll") for (int k = 0; k < 2; ++k) \
        acc[ai][bj][m][n] = __builtin_amdgcn_mfma_f32_16x16x32_bf16(Bt[n][k], At[m][k], acc[ai][bj][m][n], 0, 0, 0); __builtin_amdgcn_s_setprio(0); } while (0)
#define PG8_WAIT_V(n) asm volatile("s_waitcnt vmcnt(" #n ")" ::: "memory")
#define PG8_WAIT_L(n) asm volatile("s_waitcnt lgkmcnt(" #n ")" ::: "memory")
#define PG8_BAR __builtin_amdgcn_s_barrier()
#define PG8_SCHED __builtin_amdgcn_sched_barrier(0)
    Unit cur, nxt; int ui = 0;
    if (!S.next(0, cur)) return;
    f32x4 acc[2][2][4][2];
#pragma unroll
    for (int a = 0; a < 2; ++a)
#pragma unroll
        for (int b = 0; b < 2; ++b)
#pragma unroll
            for (int m = 0; m < 4; ++m)
#pragma unroll
                for (int n = 0; n < 2; ++n) acc[a][b][m][n] = (f32x4){0.f, 0.f, 0.f, 0.f};
    bf16x8 At[4][2], B0[2][2], B1[2][2];
    const char* cA = (const char*)g.A + (size_t)cur.pm * tstep; const char* cB = (const char*)g.Bt + (size_t)cur.pn * tstep;
    S.a_ready(cur);
    if constexpr (SP2) {
        PG8_STAGE(PG8_SB(0, 0), cB, voffB); PG8_STAGE(PG8_SB(0, 1), cB + hstep, voffB); PG8_STAGE(PG8_SA(0, 0), cA, voffA); PG8_STAGE(PG8_SA(0, 1), cA + hstep, voffA);
        if (wr == 1) PG8_BAR;
        PG8_WAIT_V(2); PG8_BAR;
        PG8_STAGE(PG8_SB(1, 0), cB + kstep, voffB); PG8_STAGE(PG8_SA(1, 0), cA + kstep, voffA); PG8_STAGE(PG8_SB(1, 1), cB + hstep + kstep, voffB);
        PG8_WAIT_V(6); PG8_BAR;
    } else {
        PG8_STAGE(PG8_SB(0, 0), cB, voffB); PG8_STAGE(PG8_SA(0, 0), cA, voffA); PG8_STAGE(PG8_SB(0, 1), cB + hstep, voffB); PG8_STAGE(PG8_SA(0, 1), cA + hstep, voffA);
        if (wr == 1) PG8_BAR;
        PG8_WAIT_V(4); PG8_BAR;
        PG8_STAGE(PG8_SB(1, 0), cB + kstep, voffB); PG8_STAGE(PG8_SA(1, 0), cA + kstep, voffA); PG8_STAGE(PG8_SB(1, 1), cB + hstep + kstep, voffB);
        PG8_WAIT_V(6); PG8_BAR;
    }
    for (;;) {
        const bool has_next = S.next(ui + 1, nxt);
        const char* nA = has_next ? (const char*)g.A + (size_t)nxt.pm * tstep : cA; const char* nB = has_next ? (const char*)g.Bt + (size_t)nxt.pn * tstep : cB;
        for (int t = 0; t < nt; t += 2) {
            const bool last = (t == nt - 2);
            const char* a1 = cA + (size_t)(t + 1) * kstep;
            const char* a2 = last ? nA : cA + (size_t)(t + 2) * kstep; const char* b2 = last ? nB : cB + (size_t)(t + 2) * kstep;
            const char* a3 = a2 + kstep; const char* b3 = b2 + kstep;
            if (last && has_next) S.a_ready(nxt);
            if constexpr (SP2) {
            PG8_LDB(B0, 0, 0); PG8_LDB(B1, 0, 1); PG8_SCHED; PG8_LDA(At, 0, 0); PG8_STAGE(PG8_SA(1, 1), a1 + hstep, voffA);
            PG8_WAIT_V(8); PG8_WAIT_L(0); PG8_BAR; PG8_MMA(0, 0, At, B0); PG8_MMA(0, 1, At, B1); PG8_BAR; PG8_SCHED;
            PG8_LDA(At, 0, 1); PG8_STAGE(PG8_SB(0, 0), b2, voffB); PG8_STAGE(PG8_SB(0, 1), b2 + hstep, voffB); PG8_STAGE(PG8_SA(0, 0), a2, voffA);
            PG8_WAIT_V(8); PG8_WAIT_L(0); PG8_BAR; PG8_MMA(1, 0, At, B0); PG8_MMA(1, 1, At, B1); PG8_BAR; PG8_SCHED;
            PG8_LDB(B0, 1, 0); PG8_LDB(B1, 1, 1); PG8_SCHED; PG8_LDA(At, 1, 0); PG8_STAGE(PG8_SA(0, 1), a2 + hstep, voffA);
            PG8_WAIT_V(8); PG8_WAIT_L(0); PG8_BAR; PG8_MMA(0, 0, At, B0); PG8_MMA(0, 1, At, B1); PG8_BAR; PG8_SCHED;
            PG8_LDA(At, 1, 1); PG8_STAGE(PG8_SB(1, 0), b3, voffB); PG8_STAGE(PG8_SB(1, 1), b3 + hstep, voffB); PG8_STAGE(PG8_SA(1, 0), a3, voffA);
            PG8_WAIT_V(8); PG8_WAIT_L(0); PG8_BAR; PG8_MMA(1, 0, At, B0); PG8_MMA(1, 1, At, B1); PG8_BAR; PG8_SCHED;
            } else {
            PG8_LDB(B0, 0, 0); PG8_SCHED; PG8_LDA(At, 0, 0); PG8_STAGE(PG8_SA(1, 1), a1 + hstep, voffA);
            PG8_WAIT_L(8); PG8_BAR; PG8_WAIT_L(0); PG8_MMA(0, 0, At, B0); PG8_BAR; PG8_SCHED;
            PG8_LDB(B1, 0, 1); PG8_STAGE(PG8_SB(0, 0), b2, voffB);
            PG8_BAR; PG8_WAIT_L(0); PG8_MMA(0, 1, At, B1); PG8_BAR;
            PG8_LDA(At, 0, 1); PG8_STAGE(PG8_SA(0, 0), a2, voffA);
            PG8_BAR; PG8_WAIT_L(0); PG8_MMA(1, 0, At, B0); PG8_BAR; PG8_SCHED;
            PG8_STAGE(PG8_SB(0, 1), b2 + hstep, voffB);
            PG8_WAIT_V(6); PG8_BAR; PG8_MMA(1, 1, At, B1); PG8_BAR;
            PG8_LDB(B0, 1, 0); PG8_SCHED; PG8_LDA(At, 1, 0); PG8_STAGE(PG8_SA(0, 1), a2 + hstep, voffA);
            PG8_WAIT_L(8); PG8_BAR; PG8_WAIT_L(0); PG8_MMA(0, 0, At, B0); PG8_BAR; PG8_SCHED;
            PG8_LDB(B1, 1, 1); PG8_STAGE(PG8_SB(1, 0), b3, voffB);
            PG8_BAR; PG8_WAIT_L(0); PG8_MMA(0, 1, At, B1); PG8_BAR;
            PG8_LDA(At, 1, 1); PG8_STAGE(PG8_SA(1, 0), a3, voffA);
            PG8_BAR; PG8_WAIT_L(0); PG8_MMA(1, 0, At, B0); PG8_BAR; PG8_SCHED;
            PG8_STAGE(PG8_SB(1, 1), b3 + hstep, voffB);
            PG8_WAIT_V(6); PG8_BAR; PG8_MMA(1, 1, At, B1); PG8_BAR;
            }
        }
        if constexpr (ALIGN_EPI) { if (wr == 0) PG8_BAR; }
        if constexpr (!Epi::AFTER_DRAIN) { E(acc, cur, wr, wc, fr, fq); S.done(cur); }
        if (!has_next) break;
#pragma unroll
        for (int a = 0; a < 2; ++a)
#pragma unroll
            for (int b = 0; b < 2; ++b)
#pragma unroll
                for (int m = 0; m < 4; ++m)
#pragma unroll
                    for (int n = 0; n < 2; ++n) acc[a][b][m][n] = (f32x4){0.f, 0.f, 0.f, 0.f};
        cur = nxt; cA = nA; cB = nB; ++ui;
        if constexpr (ALIGN_EPI) { if (wr == 1) PG8_BAR; }
    }
    PG8_WAIT_V(0);
    if constexpr (!ALIGN_EPI) { if (wr == 0) PG8_BAR; }
    PG8_BAR;
    if constexpr (Epi::AFTER_DRAIN) { E.fused(acc, cur, wr, wc, fr, fq, lds, wid, lane); S.done(cur); }
#undef PG8_SA
#undef PG8_SB
#undef PG8_STAGE
#undef PG8_LDA
#undef PG8_LDB
#undef PG8_MMA
#undef PG8_WAIT_V
#undef PG8_WAIT_L
#undef PG8_BAR
#undef PG8_SCHED
}
}
constexpr int NWAVES = 8;
constexpr int BATCH = 16, SEQ = 4096, DM = 1024, DEPTH = 4, M = BATCH * SEQ;
constexpr int IN_COLS = 3656, NIN = 3840, NIN_MAIN = 2816  , NIN_V = 1024  , DFF = 2816, NGU = 2 * DFF;
constexpr int NPH = 2 + 6 * DEPTH;
#ifndef PROBE_ATT
#define PROBE_ATT 1
#endif
#ifndef PROBE_GU
#define PROBE_GU 1
#endif
#ifndef PROBE_IDX
#define PROBE_IDX 1
#endif
#ifndef MK_PER_PHASE
#define MK_PER_PHASE 0
#endif
constexpr size_t MiB = 1u << 20;
constexpr size_t WS_CTL = 0, CTL_ZERO_BYTES = 1 * MiB;
constexpr size_t WS_WIN = 2 * MiB, WS_WOUT = 32 * MiB, WS_WGU = 40 * MiB, WS_WDN = 84 * MiB;
constexpr size_t WS_SS = 106 * MiB, WS_IW = 110 * MiB, WS_IK = 112 * MiB;
constexpr size_t WS_XB = 128 * MiB, WS_QO = 256 * MiB, WS_KK = 384 * MiB, WS_VT = 512 * MiB, WS_IQ = 640 * MiB, WS_MASK = 704 * MiB, WS_ACT = 384 * MiB, WS_MIX = 736 * MiB, WS_END = 864 * MiB;
static_assert(WS_WIN + (size_t)DEPTH * NIN * DM * 2 <= WS_WOUT && WS_WOUT + (size_t)DEPTH * DM * DM * 2 <= WS_WGU && WS_WGU + (size_t)DEPTH * NGU * DM * 2 <= WS_WDN && WS_WDN + (size_t)DEPTH * DM * DFF * 2 <= WS_SS, "weights map");
static_assert(WS_ACT + (size_t)M * DFF * 2 <= WS_MIX && WS_MASK + (size_t)M * 512 <= WS_MIX && WS_MIX + (size_t)M * 1024 * 2 <= WS_END && WS_IQ + (size_t)M * 512 * 2 <= WS_MASK && WS_KK + (size_t)M * 1024 * 2 <= WS_VT && WS_VT + (size_t)M * 1024 * 2 <= WS_IQ, "activation map");
constexpr int CW_BAR = 4096;
constexpr int RING_OFF = 0, RING_BYTES = 131072, WSCR_OFF = 131072  , BIAS_OFF = 147456  , BIAS_LD = 132, MISC_OFF = 154112, LDS_BYTES = 155648;

#define GAS __attribute__((address_space(1)))
#define LAS __attribute__((address_space(3)))
typedef unsigned short bf16;
typedef unsigned v4u __attribute__((ext_vector_type(4)));
typedef float f32x4 __attribute__((ext_vector_type(4)));
typedef GAS unsigned gu32;
#define LDS_WAIT() asm volatile("s_waitcnt lgkmcnt(0)" ::: "memory")
#define VM_WAIT() asm volatile("s_waitcnt vmcnt(0)" ::: "memory")
__device__ __forceinline__ unsigned f2bf(float f) { unsigned u = __builtin_bit_cast(unsigned, f); return (u + 0x7fffu + ((u >> 16) & 1u)) >> 16; }
__device__ __forceinline__ unsigned pk2(float lo, float hi) { return f2bf(lo) | (f2bf(hi) << 16); }
__device__ __forceinline__ float bf2f(unsigned h) { return __builtin_bit_cast(float, h << 16); }
__device__ __forceinline__ float bflo(unsigned w) { return __builtin_bit_cast(float, w << 16); }
__device__ __forceinline__ float bfhi(unsigned w) { return __builtin_bit_cast(float, w & 0xffff0000u); }
__device__ __forceinline__ float wave_sum(float v) {
#pragma unroll
    for (int o = 1; o < 64; o <<= 1) v += __shfl_xor(v, o);
    return v;
}
__device__ __forceinline__ int wave_sum_i(int v) {
#pragma unroll
    for (int o = 1; o < 64; o <<= 1) v += __shfl_xor(v, o);
    return v;
}
__device__ __forceinline__ float wave_max(float v) {
#pragma unroll
    for (int o = 1; o < 64; o <<= 1) v = fmaxf(v, __shfl_xor(v, o));
    return v;
}
__device__ __forceinline__ unsigned ukey(float f) { const unsigned b = __builtin_bit_cast(unsigned, f); return b ^ ((b >> 31) ? 0xFFFFFFFFu : 0x80000000u); }
__device__ const unsigned char T5_BUCKET[128] = {0, 1, 2, 3, 4, 5, 6, 7, 8, 9, 10, 11, 12, 13, 14, 15, 16, 16, 16, 17, 17, 18, 18, 18, 19, 19, 19, 20, 20, 20, 20, 21, 21, 21, 21, 22, 22, 22, 22, 22, 23, 23, 23, 23, 23, 23, 24, 24, 24, 24, 24, 24, 25, 25, 25, 25, 25, 25, 25, 26, 26, 26, 26, 26, 26, 26, 26, 27, 27, 27, 27, 27, 27, 27, 27, 27, 27, 28, 28, 28, 28, 28, 28, 28, 28, 28, 28, 29, 29, 29, 29, 29, 29, 29, 29, 29, 29, 29, 29, 30, 30, 30, 30, 30, 30, 30, 30, 30, 30, 30, 30, 30, 30, 31, 31, 31, 31, 31, 31, 31, 31, 31, 31, 31, 31, 31, 31, 31};
__device__ __forceinline__ const char* uni_ptr(const char* p) { const unsigned long long v = (unsigned long long)p; const unsigned lo = __builtin_amdgcn_readfirstlane((unsigned)v), hi = __builtin_amdgcn_readfirstlane((unsigned)(v >> 32)); return (const char*)(((unsigned long long)hi << 32) | lo); }
#define XB_TMO      128
#define XB_XCNT(j)  (256  + 64 * (j))
#define XB_XSUB(j)  (1280 + 64 * (j))
#define XB_XGEN(j)  (2304 + 64 * (j))
#define XB_TOP      3328
#define XB_TOPGEN   3392
#define XCD_BAR_WORDS 3456
#define XB_SPIN_CAP (1u << 18)

__device__ __forceinline__ unsigned xb_ld(unsigned* p)              { return __hip_atomic_load(p, __ATOMIC_RELAXED, __HIP_MEMORY_SCOPE_AGENT); }
__device__ __forceinline__ unsigned xb_add(unsigned* p, unsigned v) { return __hip_atomic_fetch_add(p, v, __ATOMIC_RELAXED, __HIP_MEMORY_SCOPE_AGENT); }
__device__ __forceinline__ unsigned xb_xcc_id() { return (unsigned)__builtin_amdgcn_s_getreg((3 << 11) | 20) & 0xFu; }
#define XB_SPIN(cond, bar) do { unsigned _sp = 0; while (cond) { __builtin_amdgcn_s_sleep(1); \
    if ((++_sp & 255u) == 0u) { if (xb_ld(&(bar)[XB_TMO])) break; if (_sp > XB_SPIN_CAP) { atomicAdd(&(bar)[XB_TMO], 1u); break; } } } } while (0)

struct XcdBarrier {
    unsigned* bar; unsigned x;
    volatile LAS unsigned* st;
};

__device__ __forceinline__ XcdBarrier xcd_barrier_post(unsigned* bar, volatile LAS unsigned* st) {
    XcdBarrier b; b.bar = bar; b.x = xb_xcc_id(); b.st = st;
    if (threadIdx.x == 0) (void)xb_add(&bar[XB_XCNT(b.x)], 1u);
    return b;
}
__device__ __forceinline__ void xcd_barrier_complete(unsigned* bar, unsigned x, unsigned& nloc, unsigned& nx) {
    const unsigned G = gridDim.x * gridDim.y * gridDim.z;
    unsigned sum, cnt, mine, sp = 0u;
    for (;;) {
        sum = 0u; cnt = 0u; mine = 0u;
#pragma unroll
        for (unsigned j = 0; j < 16; ++j) { const unsigned c = xb_ld(&bar[XB_XCNT(j)]); sum += c; cnt += (c > 0u) ? 1u : 0u; mine = (j == x) ? c : mine; }
        if (sum == G) break;
        __builtin_amdgcn_s_sleep(1);
        if ((++sp & 255u) == 0u) { if (xb_ld(&bar[XB_TMO])) break; if (sp > XB_SPIN_CAP) { atomicAdd(&bar[XB_TMO], 1u); break; } }
    }
    nloc = mine > 0u ? mine : 1u; nx = cnt > 0u ? cnt : 1u;
}

__device__ __forceinline__ void xcd_barrier(const XcdBarrier& b) {
    asm volatile("s_waitcnt vmcnt(0)" ::: "memory");
    __syncthreads();
    if (threadIdx.x == 0) {
        unsigned* bar = b.bar; unsigned bx = b.x; asm volatile("" : "+s"(bar), "+s"(bx));
        __builtin_amdgcn_s_waitcnt(0);
        unsigned nloc = b.st[0], nx = b.st[1];
        if (nloc == 0u) { xcd_barrier_complete(bar, bx, nloc, nx); b.st[0] = nloc; b.st[1] = nx; }
        const unsigned old = xb_add(&bar[XB_XSUB(bx)], 1u);
        const unsigned gen = old / nloc;
        if (old + 1u == (gen + 1u) * nloc) {
            __builtin_amdgcn_fence(__ATOMIC_RELEASE, "agent");
            asm volatile("s_waitcnt vmcnt(0)" ::: "memory");
            const unsigned og = xb_add(&bar[XB_TOP], 1u);
            const unsigned tg = og / nx;
            if (og + 1u == (tg + 1u) * nx) xb_add(&bar[XB_TOPGEN], 1u);
            else XB_SPIN(xb_ld(&bar[XB_TOPGEN]) == tg, bar);
            __builtin_amdgcn_fence(__ATOMIC_ACQUIRE, "agent");
            xb_add(&bar[XB_XGEN(bx)], 1u);
            asm volatile("s_waitcnt vmcnt(0)" ::: "memory");
        } else {
            XB_SPIN(xb_ld(&bar[XB_XGEN(bx)]) == gen, bar);
            __builtin_amdgcn_fence(__ATOMIC_ACQUIRE, "agent");
            asm volatile("s_waitcnt vmcnt(0)" ::: "memory");
        }
    }
    __syncthreads();
}
struct TrArgs { const float* W; const float* gain; bf16* WT; int K, N, c0, nvalid, n0, k0; };
__device__ __forceinline__ void tr_load(const TrArgs& A, float (&v)[32], float (&g8)[8], int lane) {
    const int cc = lane & 31, c = lane & 7;
#pragma unroll
    for (int j = 0; j < 8; ++j) g8[j] = A.gain ? A.gain[A.k0 + 8 * c + j] : 1.f;
#pragma unroll
    for (int i = 0; i < 32; ++i) { const int kk = 2 * i + (lane >> 5); v[i] = (cc < A.nvalid) ? A.W[(size_t)(A.k0 + kk) * A.N + A.c0 + cc] : 0.f; }
}
__device__ __forceinline__ void tr_store(const TrArgs& A, const float (&v)[32], const float (&g8)[8], LAS float* scr, int lane) {
    const int cc = lane & 31, c = lane & 7;
#pragma unroll
    for (int i = 0; i < 32; ++i) scr[(2 * i + (lane >> 5)) * 33 + cc] = v[i];
    LDS_WAIT();
#pragma unroll
    for (int j = 0; j < 4; ++j) { const int n = (lane >> 3) + 8 * j; const LAS float* s = scr + (8 * c) * 33 + n;
        v4u o; o.x = pk2(s[0 * 33] * g8[0], s[1 * 33] * g8[1]); o.y = pk2(s[2 * 33] * g8[2], s[3 * 33] * g8[3]); o.z = pk2(s[4 * 33] * g8[4], s[5 * 33] * g8[5]); o.w = pk2(s[6 * 33] * g8[6], s[7 * 33] * g8[7]);
        *(GAS v4u*)(A.WT + (size_t)(A.n0 + n) * A.K + A.k0 + 8 * c) = o; }
    LDS_WAIT();
}
struct Ptrs {
    const float *x, *attn_norm, *w_in, *diff_lambda, *diff_subln, *w_out, *ffn_norm, *w_gate, *w_up, *w_down, *rel_bias, *final_norm; float* out;
    bf16 *WIN, *WOUT, *WGU, *WDN, *IK, *XB, *QO, *KK, *VT, *IQ, *ACT, *MIX; float *SS, *IW; unsigned* MASK;
};
__device__ __forceinline__ void prologue(const Ptrs& P, LAS unsigned char* lds, int gw, int NGW, int wave, int lane) {
    LAS float* scr = (LAS float*)(lds + RING_OFF + wave * 16384);
    constexpr int I_IN = (NIN / 32) * (DM / 64), I_OUT = (DM / 32) * (DM / 64), I_GU = (NGU / 32) * (DM / 64), I_DN = (DM / 32) * (DFF / 64), I_L = I_IN + I_OUT + I_GU + I_DN;
    auto decode = [&](int it) -> TrArgs {
        TrArgs A; const int l = it / I_L; int r = it % I_L;
        if (r < I_IN) { const int db = r / (DM / 64), kb = r % (DM / 64); int c0 = 0, nv = 32;
            if (db < 16) c0 = 32 * db; else if (db < 32) c0 = 2120 + 32 * (db - 16); else if (db < 48) c0 = 512 + 32 * (db - 32); else if (db < 64) c0 = 2632 + 32 * (db - 48);
            else if (db < 80) c0 = 1536 + 32 * (db - 64); else if (db < 82) c0 = 2048 + 32 * (db - 80); else if (db == 82) { c0 = 2112; nv = 8; } else if (db < 88) { c0 = 0; nv = 0; }
            else if (db < 104) c0 = 1024 + 32 * (db - 88); else c0 = 3144 + 32 * (db - 104);
            A.W = P.w_in + (size_t)l * DM * IN_COLS; A.K = DM; A.N = IN_COLS; A.c0 = c0; A.nvalid = nv; A.gain = P.attn_norm + l * DM; A.WT = P.WIN + (size_t)l * NIN * DM; A.n0 = 32 * db; A.k0 = 64 * kb; return A; }
        r -= I_IN;
        if (r < I_OUT) { const int db = r / (DM / 64), kb = r % (DM / 64);
            A.W = P.w_out + (size_t)l * DM * DM; A.K = DM; A.N = DM; A.c0 = 32 * db; A.nvalid = 32; A.gain = nullptr; A.WT = P.WOUT + (size_t)l * DM * DM; A.n0 = 32 * db; A.k0 = 64 * kb; return A; }
        r -= I_OUT;
        if (r < I_GU) { const int db = r / (DM / 64), kb = r % (DM / 64), pn = db >> 3, wb = db & 7;
            A.W = (wb < 4 ? P.w_gate : P.w_up) + (size_t)l * DM * DFF; A.K = DM; A.N = DFF; A.c0 = 128 * pn + 32 * (wb & 3); A.nvalid = 32; A.gain = P.ffn_norm + l * DM; A.WT = P.WGU + (size_t)l * NGU * DM; A.n0 = 32 * db; A.k0 = 64 * kb; return A; }
        r -= I_GU;
        { const int db = r / (DFF / 64), kb = r % (DFF / 64);
            A.W = P.w_down + (size_t)l * DFF * DM; A.K = DFF; A.N = DM; A.c0 = 32 * db; A.nvalid = 32; A.gain = nullptr; A.WT = P.WDN + (size_t)l * DM * DFF; A.n0 = 32 * db; A.k0 = 64 * kb; return A; }
    };
    {
        constexpr int TOTAL = DEPTH * I_L;
        int it = gw; TrArgs A = decode(it < TOTAL ? it : 0); float v[32], g8[8];
        if (it < TOTAL) tr_load(A, v, g8, lane);
        for (; it < TOTAL; it += NGW) {
            const int itn = it + NGW; const bool hn = itn < TOTAL; TrArgs B = decode(hn ? itn : 0); float vn[32], gn[8];
            if (hn) tr_load(B, vn, gn, lane);
            tr_store(A, v, g8, scr, lane);
            if (hn) { A = B;
#pragma unroll
                for (int i = 0; i < 32; ++i) v[i] = vn[i];
#pragma unroll
                for (int i = 0; i < 8; ++i) g8[i] = gn[i]; }
        }
    }
    for (int m0 = 4 * gw; m0 < M; m0 += 4 * NGW) {
        f32x4 xv[4][4];
#pragma unroll
        for (int rr = 0; rr < 4; ++rr) { const GAS f32x4* xr = (const GAS f32x4*)(P.x + (size_t)(m0 + rr) * DM) + lane;
#pragma unroll
            for (int j = 0; j < 4; ++j) xv[rr][j] = xr[64 * j]; }
#pragma unroll
        for (int rr = 0; rr < 4; ++rr) { GAS unsigned long long* o8 = (GAS unsigned long long*)(P.XB + (size_t)(m0 + rr) * DM) + lane; float s = 0.f;
#pragma unroll
            for (int j = 0; j < 4; ++j) { const f32x4 v = xv[rr][j]; s += (v.x * v.x + v.y * v.y) + (v.z * v.z + v.w * v.w);
                o8[64 * j] = (unsigned long long)pk2(v.x, v.y) | ((unsigned long long)pk2(v.z, v.w) << 32); }
            s = wave_sum(s);
            if (lane < 16) P.SS[(size_t)(m0 + rr) * 16 + lane] = lane == 0 ? s : 0.f; }
    }
}
__device__ __forceinline__ void final_norm_phase(const Ptrs& P, int gw, int NGW, int lane) {
    f32x4 gg[4];
#pragma unroll
    for (int j = 0; j < 4; ++j) gg[j] = ((const GAS f32x4*)P.final_norm + lane)[64 * j];
    for (int m0 = 4 * gw; m0 < M; m0 += 4 * NGW) {
        unsigned long long xv[4][4]; float r[4];
#pragma unroll
        for (int rr = 0; rr < 4; ++rr) { const GAS unsigned long long* xr = (const GAS unsigned long long*)(P.XB + (size_t)(m0 + rr) * DM) + lane;
#pragma unroll
            for (int j = 0; j < 4; ++j) xv[rr][j] = xr[64 * j]; }
#pragma unroll
        for (int rr = 0; rr < 4; ++rr) r[rr] = pg8::row_rs(P.SS, m0 + rr);
#pragma unroll
        for (int rr = 0; rr < 4; ++rr) { GAS f32x4* o = (GAS f32x4*)(P.out + (size_t)(m0 + rr) * DM) + lane;
#pragma unroll
            for (int j = 0; j < 4; ++j) { const unsigned lo = (unsigned)xv[rr][j], hi = (unsigned)(xv[rr][j] >> 32);
                o[64 * j] = (f32x4){bflo(lo) * r[rr] * gg[j].x, bfhi(lo) * r[rr] * gg[j].y, bflo(hi) * r[rr] * gg[j].z, bfhi(hi) * r[rr] * gg[j].w}; } }
    }
}
namespace idx {
typedef short bf16x8 __attribute__((ext_vector_type(8)));
typedef float f32x4v __attribute__((ext_vector_type(4)));
typedef float f32x32 __attribute__((ext_vector_type(32)));
constexpr int KSTR = 128, CHUNK = 128, CBUF = CHUNK * KSTR, K_OFF = 0, NSL = 4, CAND_OFF = NSL * CBUF  , IDX_LDS = CAND_OFF + 8 * 8192;
#define IDX_BAR() asm volatile("s_waitcnt lgkmcnt(0)\n\ts_barrier" ::: "memory")
__device__ __forceinline__ float relu(float x) { float r; asm("v_max_f32_e32 %0, 0, %1" : "=v"(r) : "v"(x)); return r; }
__device__ __forceinline__ float min3f(float a, float b, float c) { float r; asm("v_min3_f32 %0, %1, %2, %3" : "=v"(r) : "v"(a), "v"(b), "v"(c)); return r; }
__device__ __forceinline__ float max3g(float a, float b, float c) { float r; asm("v_max3_f32 %0, %1, %2, %3" : "=v"(r) : "v"(a), "v"(b), "v"(c)); return r; }
__device__ __forceinline__ float minf_s(float a, float b) { float r; asm("v_min_f32_e32 %0, %1, %2" : "=v"(r) : "v"(a), "v"(b)); return r; }
__device__ __forceinline__ float maxf_s(float a, float b) { float r; asm("v_max_f32_e32 %0, %1, %2" : "=v"(r) : "v"(a), "v"(b)); return r; }
__device__ __forceinline__ float rfl(float x) { return __builtin_bit_cast(float, __builtin_amdgcn_readfirstlane(__builtin_bit_cast(int, x))); }
#define WRL(m, val, ln) asm("v_writelane_b32 %0, %1, %2" : "+v"(m) : "s"(val), "n"(ln))
__device__ __forceinline__ int cnt8(float s0, float s1, float s2, float s3, float s4, float s5, float s6, float s7, float thr) {
    unsigned long long m0, m1, m2, m3, m4, m5, m6, m7;
    asm("v_cmp_ge_f32_e64 %0, %8, %16\n\tv_cmp_ge_f32_e64 %1, %9, %16\n\tv_cmp_ge_f32_e64 %2, %10, %16\n\tv_cmp_ge_f32_e64 %3, %11, %16\n\t"
        "v_cmp_ge_f32_e64 %4, %12, %16\n\tv_cmp_ge_f32_e64 %5, %13, %16\n\tv_cmp_ge_f32_e64 %6, %14, %16\n\tv_cmp_ge_f32_e64 %7, %15, %16"
        : "=&s"(m0), "=&s"(m1), "=&s"(m2), "=&s"(m3), "=&s"(m4), "=&s"(m5), "=&s"(m6), "=&s"(m7)
        : "v"(s0), "v"(s1), "v"(s2), "v"(s3), "v"(s4), "v"(s5), "v"(s6), "v"(s7), "v"(thr));
    return (__builtin_popcountll(m0) + __builtin_popcountll(m1)) + (__builtin_popcountll(m2) + __builtin_popcountll(m3)) + (__builtin_popcountll(m4) + __builtin_popcountll(m5)) + (__builtin_popcountll(m6) + __builtin_popcountll(m7));
}
#define CNT8(v, g, thr) cnt8(v[8 * (g)], v[8 * (g) + 1], v[8 * (g) + 2], v[8 * (g) + 3], v[8 * (g) + 4], v[8 * (g) + 5], v[8 * (g) + 6], v[8 * (g) + 7], thr)
template <int MODE> __device__ __forceinline__ void idx_unit(const Ptrs& P, int b, int grp, bool pf, int nb, int ngrp, bool& have, bf16x8& qa0, bf16x8& qa1, f32x4v& w4, LAS unsigned char* lds, int tid, int wave, int lane) {
    asm volatile("" : "+v"(tid), "+v"(lane));
    const int t0 = 16 * grp, nkeys = t0 + 16;
    if (nkeys <= 256) {
        const int tq = t0 + 2 * wave + (lane >> 5), l32 = lane & 31;
        GAS unsigned* mrow = (GAS unsigned*)(P.MASK + (size_t)(b * SEQ + tq) * 128);
#pragma unroll
        for (int i = 0; i < 4; ++i) { const int j = l32 + 32 * i, k0 = 32 * j; mrow[j] = (k0 + 31 <= tq) ? 0xFFFFFFFFu : (k0 > tq ? 0u : ((1u << (tq - k0 + 1)) - 1u)); }
        return;
    }
    const int nch = (nkeys + CHUNK - 1) / CHUNK, tq0 = t0 + 2 * wave, tq1 = tq0 + 1;
    const int srow = 16 * wave + (lane >> 3);
    const int kcol = ((lane & 7) ^ ((srow >> 1) & 7)) * 8, kcol2 = ((lane & 7) ^ (((srow + 8) >> 1) & 7)) * 8;
    unsigned ko1 = (unsigned)(srow * 64 + kcol) * 2u, ko2 = (unsigned)((srow + 8) * 64 + kcol2) * 2u;
    const char* kg = uni_ptr((const char*)(P.IK + (size_t)b * SEQ * 64));
#define IDX_DMA2(kga, c) do { const int sl_ = (c) & (NSL - 1); const char* cb_ = (kga) + (size_t)(c) * (CHUNK * 128); asm volatile("" : "+s"(cb_)); asm volatile("" : "+v"(ko1)); asm volatile("" : "+v"(ko2)); \
        __builtin_amdgcn_global_load_lds((const unsigned*)(cb_ + ko1), (LAS unsigned*)(lds + K_OFF + sl_ * CBUF + wave * 2048), 16, 0, 0); \
        __builtin_amdgcn_global_load_lds((const unsigned*)(cb_ + ko2), (LAS unsigned*)(lds + K_OFF + sl_ * CBUF + wave * 2048 + 1024), 16, 0, 0); } while (0)
#define IDX_DMA(c) IDX_DMA2(kg, c)
#define IDX_OPERANDS(bb, tq) do { const int m_ = lane & 15, kq_ = lane >> 4, g_ = lane >> 4; const bf16* qp_ = P.IQ + (size_t)((bb) * SEQ + (tq) + (m_ >> 3)) * 512 + (m_ & 7) * 64 + 8 * kq_; \
        qa0 = *(const bf16x8*)qp_; qa1 = *(const bf16x8*)(qp_ + 32); w4 = *(const f32x4v*)(P.IW + (size_t)((bb) * SEQ + (tq) + (g_ >> 1)) * 8 + 4 * (g_ & 1)); } while (0)
    if (!have) { IDX_OPERANDS(b, tq0); IDX_DMA(0); IDX_DMA(1); IDX_DMA(2); asm volatile("" : "+v"(qa0), "+v"(qa1), "+v"(w4)); }
    asm volatile("s_waitcnt vmcnt(4)" ::: "memory");
    __builtin_amdgcn_s_barrier();
    bf16x8 qa[2] = {qa0, qa1}; float wv[4] = {w4[0], w4[1], w4[2], w4[3]};
    f32x32 a0, a1, b0, b1;
#pragma unroll
    for (int i = 0; i < 32; ++i) { a0[i] = -INFINITY; a1[i] = -INFINITY; b0[i] = -INFINITY; b1[i] = -INFINITY; }
    float mn0 = INFINITY, mn1 = INFINITY, mx0 = -INFINITY, mx1 = -INFINITY;
    const LAS unsigned char* kb = lds + K_OFF + (lane & 15) * KSTR + (((lane >> 4) ^ ((lane >> 1) & 7)) * 16);
    const int kx = (int)(((unsigned)(size_t)kb ^ 64u) - (unsigned)(size_t)kb);
#define IDX_SB() __builtin_amdgcn_sched_barrier(0)
#define IDX_MF(a, b, c) __builtin_amdgcn_mfma_f32_16x16x32_bf16(a, b, c, 0, 0, 0)
#define IDX_RL(x) x = __int_as_float(max(__float_as_int(x), 0))
#define IDX_LOADF(f0, f1, f2, f3, p) do { const LAS unsigned char* p_ = (p); f0 = *(const LAS bf16x8*)p_; f1 = *(const LAS bf16x8*)(p_ + kx); f2 = *(const LAS bf16x8*)(p_ + 16 * KSTR); f3 = *(const LAS bf16x8*)(p_ + 16 * KSTR + kx); } while (0)
#define IDX_KEEP(f0, f1, f2, f3) asm volatile("" :: "v"(f0), "v"(f1), "v"(f2), "v"(f3), "v"(ta0), "v"(ta1))
#define IDX_STEP(dn0, dn1, f0, f1, f2, f3, do0, do1) do { const f32x4v z_ = {0.f, 0.f, 0.f, 0.f}; \
        ta0 = IDX_MF(qa[0], f0, z_); IDX_SB(); IDX_RL(do0[0]); IDX_RL(do0[1]); IDX_SB(); \
        ta1 = IDX_MF(qa[0], f2, z_); IDX_SB(); IDX_RL(do0[2]); IDX_RL(do0[3]); IDX_SB(); \
        dn0 = IDX_MF(qa[1], f1, ta0); IDX_SB(); IDX_RL(do1[0]); IDX_RL(do1[1]); IDX_SB(); \
        dn1 = IDX_MF(qa[1], f3, ta1); IDX_SB(); IDX_RL(do1[2]); IDX_RL(do1[3]); IDX_SB(); } while (0)
#define IDX_SUM(r, d0, d1) do { float p0_ = wv[0] * d0[0]; p0_ = __builtin_fmaf(wv[1], d0[1], p0_); p0_ = __builtin_fmaf(wv[2], d0[2], p0_); p0_ = __builtin_fmaf(wv[3], d0[3], p0_); \
        float p1_ = wv[0] * d1[0]; p1_ = __builtin_fmaf(wv[1], d1[1], p1_); p1_ = __builtin_fmaf(wv[2], d1[2], p1_); p1_ = __builtin_fmaf(wv[3], d1[3], p1_); \
        auto rr_ = __builtin_amdgcn_permlane16_swap(__float_as_uint(p0_), __float_as_uint(p1_), false, false); r = __uint_as_float(rr_[0]) + __uint_as_float(rr_[1]); } while (0)
#define IDX_FIN(re, ro, va, vb, koff) do { auto ss_ = __builtin_amdgcn_permlane32_swap(__float_as_uint(re), __float_as_uint(ro), false, false); float A_ = __uint_as_float(ss_[0]), B_ = __uint_as_float(ss_[1]); \
        mn0 = minf_s(mn0, A_); mn1 = minf_s(mn1, B_); \
        if (CHUNK * c + CHUNK - 1 > t0) { const int k_ = CHUNK * c + (koff) + lane; A_ = k_ > tq0 ? -INFINITY : A_; B_ = k_ > tq1 ? -INFINITY : B_; } \
        mx0 = maxf_s(mx0, A_); mx1 = maxf_s(mx1, B_); va[c] = A_; vb[c] = B_; } while (0)
    bf16x8 fa0, fa1, fa2, fa3, fb0, fb1, fb2, fb3; f32x4v da0, da1, db0, db1, ta0, ta1; float re, ro;
    IDX_LOADF(fa0, fa1, fa2, fa3, kb);
    for (int c = 0; c < nch; ++c) {
        const LAS unsigned char* kc = kb + (c & (NSL - 1)) * CBUF;
        IDX_LOADF(fb0, fb1, fb2, fb3, kc + 32 * KSTR);
        IDX_SB();
        { const f32x4v z_ = {0.f, 0.f, 0.f, 0.f}; da0 = IDX_MF(qa[0], fa0, z_); da1 = IDX_MF(qa[0], fa2, z_); da0 = IDX_MF(qa[1], fa1, da0); da1 = IDX_MF(qa[1], fa3, da1); }
        IDX_SB();
        if (c + 3 < nch) IDX_DMA(c + 3);
        IDX_SB();
        IDX_STEP(db0, db1, fb0, fb1, fb2, fb3, da0, da1);
        IDX_LOADF(fa0, fa1, fa2, fa3, kc + 64 * KSTR); IDX_KEEP(fb0, fb1, fb2, fb3);
        IDX_SUM(re, da0, da1);
        IDX_SB();
        IDX_STEP(da0, da1, fa0, fa1, fa2, fa3, db0, db1);
        IDX_LOADF(fb0, fb1, fb2, fb3, kc + 96 * KSTR); IDX_KEEP(fa0, fa1, fa2, fa3);
        IDX_SUM(ro, db0, db1);
        IDX_FIN(re, ro, a0, b0, 0);
        IDX_SB();
        IDX_STEP(db0, db1, fb0, fb1, fb2, fb3, da0, da1);
        IDX_SUM(re, da0, da1);
        if (c + 3 < nch) asm volatile("s_waitcnt vmcnt(4) lgkmcnt(0)" ::: "memory"); else asm volatile("s_waitcnt vmcnt(0) lgkmcnt(0)" ::: "memory");
        __builtin_amdgcn_s_barrier();
        IDX_LOADF(fa0, fa1, fa2, fa3, kb + ((c + 1) & (NSL - 1)) * CBUF); IDX_KEEP(fb0, fb1, fb2, fb3);
        IDX_SB();
        IDX_RL(db0[0]); IDX_RL(db0[1]); IDX_RL(db0[2]); IDX_RL(db0[3]); IDX_RL(db1[0]); IDX_RL(db1[1]); IDX_RL(db1[2]); IDX_RL(db1[3]);
        IDX_SUM(ro, db0, db1);
        IDX_FIN(re, ro, a1, b1, 64);
    }
    asm volatile("s_waitcnt lgkmcnt(0)" :: "v"(fa0), "v"(fa1), "v"(fa2), "v"(fa3) : "memory");
#undef IDX_SB
#undef IDX_MF
#undef IDX_RL
#undef IDX_LOADF
#undef IDX_KEEP
#undef IDX_STEP
#undef IDX_SUM
#undef IDX_FIN
    have = false;
    if (pf) { const char* kgn = uni_ptr((const char*)(P.IK + (size_t)nb * SEQ * 64));
        IDX_OPERANDS(nb, 16 * ngrp + 2 * wave); IDX_DMA2(kgn, 0); IDX_DMA2(kgn, 1); IDX_DMA2(kgn, 2); have = true; }
#undef IDX_DMA
#undef IDX_DMA2
#undef IDX_OPERANDS
    if (MODE == 1) { float* dump = (float*)(P.MIX) + (size_t)M * 512 + ((size_t)(b * 256 + grp) * 512 + tid) * 4;
        float sa = 0.f, sb = 0.f;
#pragma unroll
        for (int i = 0; i < 32; ++i) { sa += a0[i] + a1[i]; sb += b0[i] + b1[i]; }
        dump[0] = sa; dump[1] = sb; dump[2] = mn0 + mx0; dump[3] = mn1 + mx1; return; }
#pragma unroll
    for (int m = 1; m < 64; m <<= 1) { mn0 = fminf(mn0, __shfl_xor(mn0, m)); mn1 = fminf(mn1, __shfl_xor(mn1, m)); mx0 = fmaxf(mx0, __shfl_xor(mx0, m)); mx1 = fmaxf(mx1, __shfl_xor(mx1, m)); }
    float lo0 = rfl(mn0), lo1 = rfl(mn1), hi0 = rfl(mx0), hi1 = rfl(mx1), thr0 = lo0, thr1 = lo1;
    hi0 += fmaxf(fabsf(hi0) * 1e-6f, 1e-30f); hi1 += fmaxf(fabsf(hi1) * 1e-6f, 1e-30f);
    constexpr int CAND = 512;
    bool done0 = false, done1 = false; int clo0 = tq0 + 1, clo1 = tq1 + 1, chi0 = 0, chi1 = 0;
    for (int it = 0; it < 64; ++it) {
        if ((done0 || clo0 - chi0 <= CAND) && (done1 || clo1 - chi1 <= CAND)) break;
        const float mid0 = 0.5f * lo0 + 0.5f * hi0, mid1 = 0.5f * lo1 + 0.5f * hi1;
        if (!done0 && (mid0 <= lo0 || mid0 >= hi0)) { thr0 = lo0; done0 = true; }
        if (!done1 && (mid1 <= lo1 || mid1 >= hi1)) { thr1 = lo1; done1 = true; }
        if (done0 && done1) break;
        int c0 = 0, c1 = 0;
#pragma unroll
        for (int g = 0; g < 4; ++g) if (nch > 8 * g) {
            c0 += CNT8(a0, g, mid0) + CNT8(a1, g, mid0); c1 += CNT8(b0, g, mid1) + CNT8(b1, g, mid1); }
        if (!done0) { if (c0 == 256) { thr0 = mid0; done0 = true; } else if (c0 > 256) { lo0 = mid0; clo0 = c0; } else { hi0 = mid0; chi0 = c0; } }
        if (!done1) { if (c1 == 256) { thr1 = mid1; done1 = true; } else if (c1 > 256) { lo1 = mid1; clo1 = c1; } else { hi1 = mid1; chi1 = c1; } }
    }
    LAS float* cl0 = (LAS float*)(lds + CAND_OFF + wave * 8192); LAS float* cl1 = cl0 + 1024;
    int m0 = 0, m1 = 0;
#define IDX_COMPACT(v, lo, hi, list, m) do { const float v_ = (v); const bool in_ = (v_ >= (lo)) && (v_ < (hi)); const unsigned long long bm_ = __ballot(in_); \
        if (bm_) { const int pre_ = __builtin_amdgcn_mbcnt_hi((unsigned)(bm_ >> 32), __builtin_amdgcn_mbcnt_lo((unsigned)bm_, 0u)); if (in_) (list)[(m) + pre_] = v_; (m) += __builtin_popcountll(bm_); } } while (0)
    if (!done0) {
#pragma unroll
        for (int c = 0; c < 32; ++c) if (c < nch) { IDX_COMPACT(a0[c], lo0, hi0, cl0, m0); IDX_COMPACT(a1[c], lo0, hi0, cl0, m0); } }
    if (!done1) {
#pragma unroll
        for (int c = 0; c < 32; ++c) if (c < nch) { IDX_COMPACT(b0[c], lo1, hi1, cl1, m1); IDX_COMPACT(b1[c], lo1, hi1, cl1, m1); } }
#undef IDX_COMPACT
    LDS_WAIT();
    float cr0[8], cr1[8];
#pragma unroll
    for (int k = 0; k < 8; ++k) { const int i = 64 * k + lane; cr0[k] = (i < m0) ? cl0[i] : -INFINITY; cr1[k] = (i < m1) ? cl1[i] : -INFINITY; }
    LDS_WAIT();
    const int k0 = 256 - chi0, k1 = 256 - chi1;
    for (int it = 0; it < 64; ++it) {
        const float mid0 = 0.5f * lo0 + 0.5f * hi0, mid1 = 0.5f * lo1 + 0.5f * hi1;
        if (!done0 && (mid0 <= lo0 || mid0 >= hi0)) { thr0 = lo0; done0 = true; }
        if (!done1 && (mid1 <= lo1 || mid1 >= hi1)) { thr1 = lo1; done1 = true; }
        if (done0 && done1) break;
        const int c0 = cnt8(cr0[0], cr0[1], cr0[2], cr0[3], cr0[4], cr0[5], cr0[6], cr0[7], mid0);
        const int c1 = cnt8(cr1[0], cr1[1], cr1[2], cr1[3], cr1[4], cr1[5], cr1[6], cr1[7], mid1);
        if (!done0) { if (c0 == k0) { thr0 = mid0; done0 = true; } else if (c0 > k0) lo0 = mid0; else hi0 = mid0; }
        if (!done1) { if (c1 == k1) { thr1 = mid1; done1 = true; } else if (c1 > k1) lo1 = mid1; else hi1 = mid1; }
    }
    if (!done0) thr0 = lo0;
    if (!done1) thr1 = lo1;
    if (MODE == 2) { float* dump = (float*)(P.MIX) + (size_t)M * 512 + ((size_t)(b * 256 + grp) * 512 + tid) * 4; dump[0] = thr0; dump[1] = thr1; return; }
    if (have) asm volatile("" : "+v"(qa0), "+v"(qa1), "+v"(w4));
    unsigned m0a = 0u, m0b = 0u, m1a = 0u, m1b = 0u;
#pragma unroll
    for (int c = 0; c < 32; ++c) if (c < nch) {
        const unsigned long long e0 = __ballot(a0[c] >= thr0), e1 = __ballot(a1[c] >= thr0), f0 = __ballot(b0[c] >= thr1), f1 = __ballot(b1[c] >= thr1);
        if (c < 16) { WRL(m0a, (unsigned)e0, 4 * c); WRL(m0a, (unsigned)(e0 >> 32), 4 * c + 1); WRL(m0a, (unsigned)e1, 4 * c + 2); WRL(m0a, (unsigned)(e1 >> 32), 4 * c + 3);
                      WRL(m1a, (unsigned)f0, 4 * c); WRL(m1a, (unsigned)(f0 >> 32), 4 * c + 1); WRL(m1a, (unsigned)f1, 4 * c + 2); WRL(m1a, (unsigned)(f1 >> 32), 4 * c + 3); }
        else { const int cc = c - 16;
               WRL(m0b, (unsigned)e0, 4 * cc); WRL(m0b, (unsigned)(e0 >> 32), 4 * cc + 1); WRL(m0b, (unsigned)e1, 4 * cc + 2); WRL(m0b, (unsigned)(e1 >> 32), 4 * cc + 3);
               WRL(m1b, (unsigned)f0, 4 * cc); WRL(m1b, (unsigned)(f0 >> 32), 4 * cc + 1); WRL(m1b, (unsigned)f1, 4 * cc + 2); WRL(m1b, (unsigned)(f1 >> 32), 4 * cc + 3); }
    }
    { GAS unsigned* r0 = (GAS unsigned*)(P.MASK + (size_t)(b * SEQ + tq0) * 128); GAS unsigned* r1 = (GAS unsigned*)(P.MASK + (size_t)(b * SEQ + tq1) * 128);
      r0[lane] = m0a; r0[64 + lane] = m0b; r1[lane] = m1a; r1[64 + lane] = m1b; }
}
template <int MODE> __device__ __forceinline__ void idx_phase(const Ptrs& P, LAS unsigned char* lds, int bid, int G, int tid, int wave, int lane) {
    for (int vb = bid; vb < 256; vb += G) {
        const int vcu = (vb & 7) * 32 + (vb >> 3);
        bf16x8 qa0, qa1; f32x4v w4; bool have = false;
        for (int b = 0; b < BATCH; ++b) { const int grp = (b & 1) ? 255 - vcu : vcu, nb = b + 1, ngrp = (nb & 1) ? 255 - vcu : vcu;
            idx_unit<MODE>(P, b, grp, nb < BATCH && 16 * ngrp + 16 > 256, nb, ngrp, have, qa0, qa1, w4, lds, tid, wave, lane); }
    }
}
#undef IDX_BAR
}

namespace att {
typedef short bf16x8 __attribute__((ext_vector_type(8)));
typedef float f32x16 __attribute__((ext_vector_type(16)));
typedef unsigned u32x2 __attribute__((ext_vector_type(2)));
typedef float f32x2v __attribute__((ext_vector_type(2)));
constexpr int NSLOT = 4, KSLOT = 8192, VSLOT = 16384;
constexpr int K_OFF = 0, V_OFF = NSLOT * KSLOT, WSF_OFF = V_OFF + NSLOT * VSLOT, OST_OFF = V_OFF  , MSK_OFF = WSF_OFF + 8 * 256  , ATT_LDS = MSK_OFF + 8 * 4096;
__device__ __forceinline__ int crow(int r, int hi) { return (r & 3) + 8 * (r >> 2) + 4 * hi; }
#define ATT_BAR() asm volatile("s_waitcnt lgkmcnt(0)\n\ts_barrier" ::: "memory")
__device__ __forceinline__ float swap_max(float m) { auto rr = __builtin_amdgcn_permlane32_swap(__float_as_uint(m), __float_as_uint(m), false, false); return fmaxf(__uint_as_float(rr[0]), __uint_as_float(rr[1])); }
__device__ __forceinline__ float swap_sum(float m) { auto rr = __builtin_amdgcn_permlane32_swap(__float_as_uint(m), __float_as_uint(m), false, false); return __uint_as_float(rr[0]) + __uint_as_float(rr[1]); }
__device__ __forceinline__ unsigned cvtpk(float lo, float hi) { unsigned r; asm("v_cvt_pk_bf16_f32 %0, %1, %2" : "=v"(r) : "v"(lo), "v"(hi)); return r; }
__device__ __forceinline__ float fadd_s(float a, float b) { float r; asm("v_add_f32_e32 %0, %1, %2" : "=v"(r) : "v"(a), "v"(b)); return r; }
__device__ __forceinline__ float fsub_s(float a, float b) { float r; asm("v_sub_f32_e32 %0, %1, %2" : "=v"(r) : "v"(a), "v"(b)); return r; }
__device__ __forceinline__ float max3f(float a, float b, float c) { float r; asm("v_max3_f32 %0, %1, %2, %3" : "=v"(r) : "v"(a), "v"(b), "v"(c)); return r; }
__device__ __forceinline__ int med3i(int a, int b, int c) { int r; asm("v_med3_i32 %0, %1, %2, %3" : "=v"(r) : "v"(a), "v"(b), "v"(c)); return r; }
__device__ __forceinline__ unsigned bfe1(unsigned w, int c) { unsigned r; asm("v_bfe_i32 %0, %1, %2, 1" : "=v"(r) : "v"(w), "n"(c)); return r; }
typedef float f32x2m __attribute__((ext_vector_type(2)));
typedef __bf16 bf16x2m __attribute__((ext_vector_type(2)));
__device__ __forceinline__ unsigned cvtpk_m(float lo, float hi) { const f32x2m v = {lo, hi}; const bf16x2m b = __builtin_convertvector(v, bf16x2m); return __builtin_bit_cast(unsigned, b); }
__device__ __forceinline__ bf16x8 pack8m(const f32x16& p, int b) { v4u w; w.x = cvtpk_m(p[b], p[b + 1]); w.y = cvtpk_m(p[b + 2], p[b + 3]); w.z = cvtpk_m(p[b + 4], p[b + 5]); w.w = cvtpk_m(p[b + 6], p[b + 7]); return __builtin_bit_cast(bf16x8, w); }
__device__ __forceinline__ bf16x8 pack8(const f32x16& p, int b) { v4u w; w.x = cvtpk(p[b], p[b + 1]); w.y = cvtpk(p[b + 2], p[b + 3]); w.z = cvtpk(p[b + 4], p[b + 5]); w.w = cvtpk(p[b + 6], p[b + 7]); return __builtin_bit_cast(bf16x8, w); }

template <int DV, bool MASKED>
__device__ __forceinline__ void attn_pass(f32x16 (&o)[DV / 32], const bf16* Q, const bf16* K, const bf16* VT, const unsigned* MASKb, const LAS float* bias,
                                          int q0, int nt, LAS unsigned char* lds, int tid, int wave, int lane) {
    asm volatile("" : "+v"(tid), "+v"(lane));
    const int r32 = lane & 31, hi = lane >> 5, qw0 = q0 + 32 * wave, qpos = qw0 + r32, tmax = (qw0 + 31) >> 6;
    bf16x8 qf[4];
#pragma unroll
    for (int s = 0; s < 4; ++s) qf[s] = *(const bf16x8*)(Q + (size_t)qpos * 1024 + 16 * s + 8 * hi);
    const int srow = 8 * wave + (lane >> 3), spc = ((lane & 7) ^ ((srow >> 1) & 7)) * 8;
    unsigned koff = (unsigned)(srow * 1024 + spc) * 2u, voff = (unsigned)(srow * M + spc) * 2u, moff = (unsigned)qpos * 512u;
    const char* Ku = uni_ptr((const char*)K); const char* Vu = uni_ptr((const char*)VT); const char* Mu = MASKED ? uni_ptr((const char*)MASKb) : nullptr;
    LAS float* wsf = (LAS float*)(lds + WSF_OFF + wave * 256);
    constexpr bool SPLIT = !MASKED && DV == 128;
    constexpr int KV_OPS = 1 + DV / 64 + (MASKED ? 1 : 0);
    static_assert(KV_OPS == 3, "the counted waits assume three LDS-DMA operations per tile per wave");
#define ATT_VB(v) asm volatile("" : "+v"(v))
#define ATT_SB(p) asm volatile("" : "+s"(p))
#define ATT_DMA(t) do { const int sl_ = (t) & (NSLOT - 1); \
        if (MASKED) { const char* mb_ = Mu + (size_t)(16 * ((t) >> 1)); ATT_SB(mb_); ATT_VB(moff); __builtin_amdgcn_global_load_lds((const unsigned*)(mb_ + moff), (LAS unsigned*)(lds + MSK_OFF + wave * 4096 + sl_ * 1024), 16, 0, 0); } \
        { const char* kb_ = Ku + (size_t)(t) * 131072; ATT_SB(kb_); ATT_VB(koff); __builtin_amdgcn_global_load_lds((const unsigned*)(kb_ + koff), (LAS unsigned*)(lds + K_OFF + sl_ * KSLOT + wave * 1024), 16, 0, 0); } \
        _Pragma("unroll") for (int i_ = 0; i_ < DV / 64; ++i_) { const char* vb_ = Vu + ((size_t)i_ * 128 * M + (size_t)(t) * 128); ATT_SB(vb_); ATT_VB(voff); \
            __builtin_amdgcn_global_load_lds((const unsigned*)(vb_ + voff), (LAS unsigned*)(lds + V_OFF + sl_ * VSLOT + i_ * 8192 + wave * 1024), 16, 0, 0); } } while (0)
    asm volatile("s_waitcnt lgkmcnt(0)\n\ts_barrier" ::: "memory");
    ATT_DMA(0);
    if (nt > 1) ATT_DMA(1);
    if (nt > 2) ATT_DMA(2);
    int xo[4];
#pragma unroll
    for (int s = 0; s < 4; ++s) xo[s] = r32 * 128 + (((2 * s + hi) ^ ((r32 >> 1) & 7)) * 16);
    if (nt > 2) asm volatile("s_waitcnt vmcnt(3)" ::: "memory");
    else asm volatile("s_waitcnt vmcnt(0)" ::: "memory");
    __builtin_amdgcn_s_barrier();
    bf16x8 kf[8];
#pragma unroll
    for (int s = 0; s < 4; ++s) { kf[2 * s] = *(const LAS bf16x8*)(lds + K_OFF + xo[s]); kf[2 * s + 1] = *(const LAS bf16x8*)(lds + K_OFF + xo[s] + 4096); }
    float lsum = 0.f, one = 1.f; asm volatile("" : "+v"(one));
    f32x16 negm;
#pragma unroll
    for (int r = 0; r < 16; ++r) negm[r] = 0.f;
#pragma unroll
    for (int d0 = 0; d0 < DV / 32; ++d0)
#pragma unroll
        for (int r = 0; r < 16; ++r) o[d0][r] = 0.f;
    for (int t = 0; t < nt; ++t) {
        const int slot = t & (NSLOT - 1);
        if (t <= tmax) {
            f32x16 p0, p1;
            const LAS unsigned char* vb = lds + V_OFF + slot * VSLOT;
            bf16x8 vf[8], vg2[DV == 128 ? 8 : 1]; u32x2 mw = {0u, 0u};
            __builtin_amdgcn_sched_barrier(0);
#pragma unroll
            for (int s = 0; s < 4; ++s) { p0 = __builtin_amdgcn_mfma_f32_32x32x16_bf16(kf[2 * s], qf[s], s == 0 ? negm : p0, 0, 0, 0); p1 = __builtin_amdgcn_mfma_f32_32x32x16_bf16(kf[2 * s + 1], qf[s], s == 0 ? negm : p1, 0, 0, 0); }
            __builtin_amdgcn_sched_barrier(0);
            if (t + 3 < nt) ATT_DMA(t + 3);
            __builtin_amdgcn_sched_barrier(0);
            asm volatile("s_nop 15" : "+v"(p0), "+v"(p1));
            __builtin_amdgcn_sched_barrier(0);
            const int kv0 = 64 * t;
            if (kv0 + 63 + 113 > qw0) {
                const int dq = qpos - kv0 - 4 * hi + 1;
#pragma unroll
                for (int r = 0; r < 16; ++r) { const int d = dq - ((r & 3) + 8 * (r >> 2));
                    p0[r] += bias[med3i(d, 0, 128)]; p1[r] += bias[med3i(d - 32, 0, 128)]; }
            }
            float rm;
            { float a = max3f(p0[0], p0[1], p1[0]), b = max3f(p0[2], p0[3], p1[1]); a = max3f(a, p1[2], p1[3]);
#pragma unroll
              for (int r = 4; r < 16; r += 4) { a = max3f(a, p0[r], p0[r + 1]); b = max3f(b, p0[r + 2], p0[r + 3]); a = max3f(a, p1[r], p1[r + 1]); b = max3f(b, p1[r + 2], p1[r + 3]); }
              rm = swap_max(max3f(a, b, b)); }
            if (__any(rm > 8.f) || t == 0) {
                const float dl = (t == 0) ? (rm == -INFINITY ? 0.f : rm) : fmaxf(rm, 0.f), f = (t == 0) ? 1.f : __builtin_amdgcn_exp2f(-dl); lsum *= f;
#pragma unroll
                for (int r = 0; r < 16; ++r) negm[r] -= dl;
#pragma unroll
                for (int r = 0; r < 16; ++r) { p0[r] -= dl; p1[r] -= dl; }
                if (hi == 0) wsf[r32] = f;
                LDS_WAIT();
#pragma unroll
                for (int r = 0; r < 16; ++r) { const float fr = wsf[crow(r, hi)];
#pragma unroll
                    for (int d0 = 0; d0 < DV / 32; ++d0) o[d0][r] *= fr; }
                LDS_WAIT();
            }
            if (DV == 64) {
#pragma unroll
            for (int j = 0; j < 4; ++j) { vf[j] = *(const LAS bf16x8*)(vb + xo[j]); vf[4 + j] = *(const LAS bf16x8*)(vb + xo[j] + 4096); } }
            if (DV == 128) {
#pragma unroll
                for (int j = 0; j < 4; ++j) { vg2[DV == 128 ? j : 0] = *(const LAS bf16x8*)(vb + xo[j] + 8192); vg2[DV == 128 ? 4 + j : 0] = *(const LAS bf16x8*)(vb + xo[j] + 12288); } }
            if (SPLIT) {
#pragma unroll
            for (int j = 0; j < 4; ++j) { vf[j] = *(const LAS bf16x8*)(vb + xo[j]); vf[4 + j] = *(const LAS bf16x8*)(vb + xo[j] + 4096); } }
            if (DV == 128 && !SPLIT) {
            if (t + 1 < nt) { const LAS unsigned char* kn = lds + K_OFF + ((t + 1) & (NSLOT - 1)) * KSLOT;
#pragma unroll
                for (int s = 0; s < 4; ++s) { kf[2 * s] = *(const LAS bf16x8*)(kn + xo[s]); kf[2 * s + 1] = *(const LAS bf16x8*)(kn + xo[s] + 4096); } }
            }
            bf16x8 pa0, pa1, pa2, pa3;
            if (MASKED) {
#pragma unroll
            for (int r = 0; r < 16; ++r) { p0[r] = __builtin_amdgcn_exp2f(p0[r]); p1[r] = __builtin_amdgcn_exp2f(p1[r]); }
            } else {
            if (SPLIT) {
#pragma unroll
            for (int r = 0; r < 16; ++r) p0[r] = __builtin_amdgcn_exp2f(p0[r]);
            float sa = p0[0];
#pragma unroll
            for (int r = 1; r < 16; ++r) sa += p0[r];
            pa0 = pack8m(p0, 0); pa1 = pack8m(p0, 8);
            lsum += sa;
            } else {
#pragma unroll
            for (int r = 0; r < 16; ++r) { p0[r] = __builtin_amdgcn_exp2f(p0[r]); p1[r] = __builtin_amdgcn_exp2f(p1[r]); }
            float sa = p0[0], sb = p1[0];
#pragma unroll
            for (int r = 1; r < 16; ++r) { sa += p0[r]; sb = __builtin_fmaf(p1[r], one, sb); }
            pa0 = pack8m(p0, 0); pa1 = pack8m(p0, 8); pa2 = pack8m(p1, 0); pa3 = pack8m(p1, 8);
            lsum += sa + sb;
            }
            }
            if (MASKED) { mw = *(const LAS u32x2*)(lds + MSK_OFF + wave * 4096 + slot * 1024 + r32 * 16 + (t & 1) * 8); const unsigned w0 = mw.x >> (4 * hi), w1 = mw.y >> (4 * hi);
                p0[0] = __uint_as_float(__float_as_uint(p0[0]) & bfe1(w0, 0)); p1[0] = __uint_as_float(__float_as_uint(p1[0]) & bfe1(w1, 0));
                p0[1] = __uint_as_float(__float_as_uint(p0[1]) & bfe1(w0, 1)); p1[1] = __uint_as_float(__float_as_uint(p1[1]) & bfe1(w1, 1));
                p0[2] = __uint_as_float(__float_as_uint(p0[2]) & bfe1(w0, 2)); p1[2] = __uint_as_float(__float_as_uint(p1[2]) & bfe1(w1, 2));
                p0[3] = __uint_as_float(__float_as_uint(p0[3]) & bfe1(w0, 3)); p1[3] = __uint_as_float(__float_as_uint(p1[3]) & bfe1(w1, 3));
                p0[4] = __uint_as_float(__float_as_uint(p0[4]) & bfe1(w0, 8)); p1[4] = __uint_as_float(__float_as_uint(p1[4]) & bfe1(w1, 8));
                p0[5] = __uint_as_float(__float_as_uint(p0[5]) & bfe1(w0, 9)); p1[5] = __uint_as_float(__float_as_uint(p1[5]) & bfe1(w1, 9));
                p0[6] = __uint_as_float(__float_as_uint(p0[6]) & bfe1(w0, 10)); p1[6] = __uint_as_float(__float_as_uint(p1[6]) & bfe1(w1, 10));
                p0[7] = __uint_as_float(__float_as_uint(p0[7]) & bfe1(w0, 11)); p1[7] = __uint_as_float(__float_as_uint(p1[7]) & bfe1(w1, 11));
                p0[8] = __uint_as_float(__float_as_uint(p0[8]) & bfe1(w0, 16)); p1[8] = __uint_as_float(__float_as_uint(p1[8]) & bfe1(w1, 16));
                p0[9] = __uint_as_float(__float_as_uint(p0[9]) & bfe1(w0, 17)); p1[9] = __uint_as_float(__float_as_uint(p1[9]) & bfe1(w1, 17));
                p0[10] = __uint_as_float(__float_as_uint(p0[10]) & bfe1(w0, 18)); p1[10] = __uint_as_float(__float_as_uint(p1[10]) & bfe1(w1, 18));
                p0[11] = __uint_as_float(__float_as_uint(p0[11]) & bfe1(w0, 19)); p1[11] = __uint_as_float(__float_as_uint(p1[11]) & bfe1(w1, 19));
                p0[12] = __uint_as_float(__float_as_uint(p0[12]) & bfe1(w0, 24)); p1[12] = __uint_as_float(__float_as_uint(p1[12]) & bfe1(w1, 24));
                p0[13] = __uint_as_float(__float_as_uint(p0[13]) & bfe1(w0, 25)); p1[13] = __uint_as_float(__float_as_uint(p1[13]) & bfe1(w1, 25));
                p0[14] = __uint_as_float(__float_as_uint(p0[14]) & bfe1(w0, 26)); p1[14] = __uint_as_float(__float_as_uint(p1[14]) & bfe1(w1, 26));
                p0[15] = __uint_as_float(__float_as_uint(p0[15]) & bfe1(w0, 27)); p1[15] = __uint_as_float(__float_as_uint(p1[15]) & bfe1(w1, 27));
            }
            if (MASKED) { float sa = fadd_s(p0[0], p1[0]), sb = fadd_s(p0[1], p1[1]);
#pragma unroll
              for (int r = 2; r < 16; r += 2) { sa = fadd_s(sa, p0[r]); sb = fadd_s(sb, p0[r + 1]); sa = fadd_s(sa, p1[r]); sb = fadd_s(sb, p1[r + 1]); }
              lsum += sa + sb;
              pa0 = pack8(p0, 0); pa1 = pack8(p0, 8); pa2 = pack8(p1, 0); pa3 = pack8(p1, 8); }
            __builtin_amdgcn_sched_barrier(0);
            if (DV != 128) {
            if (t + 1 < nt) { const LAS unsigned char* kn = lds + K_OFF + ((t + 1) & (NSLOT - 1)) * KSLOT;
#pragma unroll
                for (int s = 0; s < 4; ++s) { kf[2 * s] = *(const LAS bf16x8*)(kn + xo[s]); kf[2 * s + 1] = *(const LAS bf16x8*)(kn + xo[s] + 4096); } }
            }
            if (DV == 128 && !SPLIT) {
#pragma unroll
            for (int j = 0; j < 4; ++j) { vf[j] = *(const LAS bf16x8*)(vb + xo[j]); vf[4 + j] = *(const LAS bf16x8*)(vb + xo[j] + 4096); } }
            __builtin_amdgcn_sched_barrier(0);
            if (SPLIT) {
                float sa = 0.f, f0 = 0.f, f1 = 0.f; unsigned w0 = 0u, w1 = 0u, w2 = 0u, w3 = 0u, w4 = 0u, w5 = 0u, w6 = 0u, w7 = 0u;
#define ATT_W(k, v) do { if ((k) == 0) w0 = (v); else if ((k) == 1) w1 = (v); else if ((k) == 2) w2 = (v); else if ((k) == 3) w3 = (v); else if ((k) == 4) w4 = (v); else if ((k) == 5) w5 = (v); else if ((k) == 6) w6 = (v); else w7 = (v); } while (0)
#pragma unroll
                for (int k = 0; k < 8; ++k) {
                    const int j = (k >> 1) & 1, d = (k < 4 ? 2 : 0) + (k & 1);
                    o[DV == 128 ? d : 0] = __builtin_amdgcn_mfma_f32_32x32x16_bf16(j == 0 ? pa0 : pa1, d < 2 ? vf[4 * (d & 1) + j] : vg2[DV == 128 ? 4 * (d & 1) + j : 0], o[DV == 128 ? d : 0], 0, 0, 0);
                    const float e0 = __builtin_amdgcn_exp2f(p1[2 * k]), e1 = __builtin_amdgcn_exp2f(p1[2 * k + 1]);
                    if (k > 0) { sa += f0; sa += f1; ATT_W(k - 1, cvtpk_m(f0, f1)); }
                    f0 = e0; f1 = e1;
                    __builtin_amdgcn_sched_group_barrier(0x008, 1, 0); __builtin_amdgcn_sched_group_barrier(0x400, 2, 0); __builtin_amdgcn_sched_group_barrier(0x002, 3, 0);
                }
                sa += f0; sa += f1; w7 = cvtpk_m(f0, f1);
                lsum += sa;
                { v4u q; q.x = w0; q.y = w1; q.z = w2; q.w = w3; pa2 = __builtin_bit_cast(bf16x8, q); q.x = w4; q.y = w5; q.z = w6; q.w = w7; pa3 = __builtin_bit_cast(bf16x8, q); }
#undef ATT_W
                __builtin_amdgcn_sched_barrier(0);
                { const LAS unsigned char* kn = lds + K_OFF + ((t + 1) & (NSLOT - 1)) * KSLOT;
#pragma unroll
                    for (int s = 0; s < 4; ++s) { kf[2 * s] = *(const LAS bf16x8*)(kn + xo[s]); kf[2 * s + 1] = *(const LAS bf16x8*)(kn + xo[s] + 4096); } }
                __builtin_amdgcn_sched_barrier(0);
#pragma unroll
                for (int k = 0; k < 8; ++k) {
                    const int j = (k >> 1) & 1, d = (k < 4 ? 2 : 0) + (k & 1);
                    o[DV == 128 ? d : 0] = __builtin_amdgcn_mfma_f32_32x32x16_bf16(j == 0 ? pa2 : pa3, d < 2 ? vf[4 * (d & 1) + 2 + j] : vg2[DV == 128 ? 4 * (d & 1) + 2 + j : 0], o[DV == 128 ? d : 0], 0, 0, 0);
                }
            } else {
            if (DV == 128) {
#pragma unroll
                for (int d0 = 0; d0 < 2; ++d0)
#pragma unroll
                    for (int j = 0; j < 4; ++j) o[DV == 128 ? 2 + d0 : d0] = __builtin_amdgcn_mfma_f32_32x32x16_bf16(j == 0 ? pa0 : j == 1 ? pa1 : j == 2 ? pa2 : pa3, vg2[DV == 128 ? 4 * d0 + j : 0], o[DV == 128 ? 2 + d0 : d0], 0, 0, 0);
            }
#pragma unroll
            for (int d0 = 0; d0 < 2; ++d0)
#pragma unroll
                for (int j = 0; j < 4; ++j) o[d0] = __builtin_amdgcn_mfma_f32_32x32x16_bf16(j == 0 ? pa0 : j == 1 ? pa1 : j == 2 ? pa2 : pa3, vf[4 * d0 + j], o[d0], 0, 0, 0);
            }
            __builtin_amdgcn_sched_barrier(0);
        }
        if (t + 3 < nt) asm volatile("s_waitcnt vmcnt(3) lgkmcnt(0)" ::: "memory");
        else asm volatile("s_waitcnt vmcnt(0) lgkmcnt(0)" ::: "memory");
        __builtin_amdgcn_s_barrier();
    }
#undef ATT_DMA
#undef ATT_SB
#undef ATT_VB
    { float gt;
      if (DV == 128) asm volatile("v_mov_b32 %0, %1\n\tv_mov_b32 %0, %2\n\tv_mov_b32 %0, %3\n\tv_mov_b32 %0, %4\n\ts_nop 1" : "=&v"(gt) : "v"(o[1][15]), "v"(o[0][15]), "v"(o[DV == 128 ? 3 : 1][15]), "v"(o[DV == 128 ? 2 : 0][15]));
      else asm volatile("v_mov_b32 %0, %1\n\tv_mov_b32 %0, %2\n\ts_nop 1" : "=&v"(gt) : "v"(o[1][15]), "v"(o[0][15]));
      asm volatile("" :: "v"(gt)); }
    lsum = swap_sum(lsum);
    if (hi == 0) wsf[r32] = __builtin_amdgcn_rcpf(lsum);
    LDS_WAIT();
#pragma unroll
    for (int r = 0; r < 16; ++r) { const float fr = wsf[crow(r, hi)];
#pragma unroll
        for (int d0 = 0; d0 < DV / 32; ++d0) o[d0][r] *= fr; }
    LDS_WAIT();
}
#define PA_SB() __builtin_amdgcn_sched_barrier(0)
#define PA_PIN(x) asm volatile("" : "+v"(x))
#define PA_KEEP(x) asm volatile("" :: "v"(x))
#define PA_MF(a, b, c) __builtin_amdgcn_mfma_f32_32x32x16_bf16(a, b, c, 0, 0, 0)
#define PA_MFMA_DONE(acc0, acc1) do { float t_; asm volatile("s_nop 15\n\tv_mov_b32 %0, %1\n\tv_mov_b32 %0, %2\n\ts_nop 1" : "=&v"(t_) : "v"(acc0[15]), "v"(acc1[15])); asm volatile("" :: "v"(t_)); } while (0)
template <bool MASKED>
__device__ __forceinline__ void attn_pass_p64(f32x16 (&o)[2], const bf16* Q, const bf16* K, const bf16* VT, const unsigned* MASKb, const LAS float* bias,
                                              int q0, int nt, LAS unsigned char* lds, int tid, int wave, int lane) {
    asm volatile("" : "+v"(tid), "+v"(lane));
    const int r32 = lane & 31, hi = lane >> 5, qw0 = q0 + 32 * wave, qpos = qw0 + r32;
    bf16x8 qf[4];
#pragma unroll
    for (int s = 0; s < 4; ++s) qf[s] = *(const bf16x8*)(Q + (size_t)qpos * 1024 + 16 * s + 8 * hi);
    const int srow = 8 * wave + (lane >> 3), spc = ((lane & 7) ^ ((srow >> 1) & 7)) * 8;
    unsigned koff = (unsigned)(srow * 1024 + spc) * 2u, voff = (unsigned)(srow * M + spc) * 2u, moff = (unsigned)qpos * 512u;
    const char* Ku = uni_ptr((const char*)K); const char* Vu = uni_ptr((const char*)VT); const char* Mu = MASKED ? uni_ptr((const char*)MASKb) : nullptr;
    LAS float* wsf = (LAS float*)(lds + WSF_OFF + wave * 256);
#define PA_DK(t) do { const char* b_ = Ku + (size_t)(t) * 131072; asm volatile("" : "+s"(b_)); asm volatile("" : "+v"(koff)); \
        __builtin_amdgcn_global_load_lds((const unsigned*)(b_ + koff), (LAS unsigned*)(lds + K_OFF + ((t) & 3) * KSLOT + wave * 1024), 16, 0, 0); } while (0)
#define PA_DV(t) do { const char* b_ = Vu + (size_t)(t) * 128; asm volatile("" : "+s"(b_)); asm volatile("" : "+v"(voff)); \
        __builtin_amdgcn_global_load_lds((const unsigned*)(b_ + voff), (LAS unsigned*)(lds + V_OFF + ((t) & 3) * VSLOT + wave * 1024), 16, 0, 0); } while (0)
#define PA_DM(t) do { if (MASKED) { const char* b_ = Mu + (size_t)(16 * ((t) >> 1)); asm volatile("" : "+s"(b_)); asm volatile("" : "+v"(moff)); \
        __builtin_amdgcn_global_load_lds((const unsigned*)(b_ + moff), (LAS unsigned*)(lds + MSK_OFF + wave * 4096 + ((t) & 3) * 1024), 16, 0, 0); } } while (0)
    constexpr int NOPS = MASKED ? 3 : 2;
    asm volatile("s_waitcnt lgkmcnt(0)\n\ts_barrier" ::: "memory");
    PA_DM(0); PA_DK(0); PA_DV(0); PA_DM(1); PA_DK(1); PA_DV(1); PA_DK(2);
    int xo[4];
#pragma unroll
    for (int s = 0; s < 4; ++s) xo[s] = r32 * 128 + (((2 * s + hi) ^ ((r32 >> 1) & 7)) * 16);
    asm volatile("s_waitcnt vmcnt(1)" ::: "memory");
    __builtin_amdgcn_s_barrier();
    bf16x8 kf[8], vf[8]; v4u pw0, pw1, pw2, pw3; f32x16 pA0, pA1, pB0, pB1;
    float lsum = 0.f; bool resc = false;
    f32x16 negm;
#pragma unroll
    for (int r = 0; r < 16; ++r) { o[0][r] = 0.f; o[1][r] = 0.f; negm[r] = 0.f; }
#define PA_KLD(s, tt) do { const LAS unsigned char* kn_ = lds + K_OFF + ((tt) & 3) * KSLOT; PA_KEEP(kf[2 * (s)]); PA_KEEP(kf[2 * (s) + 1]); kf[2 * (s)] = *(const LAS bf16x8*)(kn_ + xo[s]); kf[2 * (s) + 1] = *(const LAS bf16x8*)(kn_ + xo[s] + 4096); } while (0)
#define PA_BIAS(C0, C1, tt) do { const int kv0_ = 64 * (tt); if (kv0_ + 63 + 113 > qw0) { const int dq_ = qpos - kv0_ - 4 * hi + 1; \
        _Pragma("unroll") for (int r = 0; r < 16; ++r) { const int d_ = dq_ - ((r & 3) + 8 * (r >> 2)); C0[r] += bias[med3i(d_, 0, 128)]; C1[r] += bias[med3i(d_ - 32, 0, 128)]; } } } while (0)
#define PA_ROWMAX(rm, C0, C1) do { float a_ = max3f(C0[0], C0[1], C1[0]), b_ = max3f(C0[2], C0[3], C1[1]); a_ = max3f(a_, C1[2], C1[3]); \
        _Pragma("unroll") for (int r = 4; r < 16; r += 4) { a_ = max3f(a_, C0[r], C0[r + 1]); b_ = max3f(b_, C0[r + 2], C0[r + 3]); a_ = max3f(a_, C1[r], C1[r + 1]); b_ = max3f(b_, C1[r + 2], C1[r + 3]); } \
        rm = swap_max(max3f(a_, b_, b_)); } while (0)
#define PA_EXP4(X, i) do { X[i] = __builtin_amdgcn_exp2f(X[i]); X[(i) + 1] = __builtin_amdgcn_exp2f(X[(i) + 1]); X[(i) + 2] = __builtin_amdgcn_exp2f(X[(i) + 2]); X[(i) + 3] = __builtin_amdgcn_exp2f(X[(i) + 3]); PA_PIN(X); } while (0)
#pragma unroll
    for (int s = 0; s < 4; ++s) { kf[2 * s] = *(const LAS bf16x8*)(lds + K_OFF + xo[s]); kf[2 * s + 1] = *(const LAS bf16x8*)(lds + K_OFF + xo[s] + 4096); }
    PA_SB();
    { const f32x16 z16 = {0.f, 0.f, 0.f, 0.f, 0.f, 0.f, 0.f, 0.f, 0.f, 0.f, 0.f, 0.f, 0.f, 0.f, 0.f, 0.f};
#pragma unroll
      for (int s = 0; s < 4; ++s) { pA0 = PA_MF(kf[2 * s], qf[s], s == 0 ? z16 : pA0); pA1 = PA_MF(kf[2 * s + 1], qf[s], s == 0 ? z16 : pA1); } }
    PA_SB();
    PA_DM(2); PA_DV(2); PA_DK(3);
    PA_SB();
    asm volatile("s_nop 15\n\ts_nop 7" : "+v"(pA0), "+v"(pA1));
    PA_BIAS(pA0, pA1, 0);
    { float rm; PA_ROWMAX(rm, pA0, pA1); const float m0_ = (rm == -INFINITY) ? 0.f : rm;
#pragma unroll
      for (int r = 0; r < 16; ++r) { pA0[r] -= m0_; pA1[r] -= m0_; negm[r] = -m0_; } }
    PA_EXP4(pA0, 0); PA_EXP4(pA0, 4); PA_EXP4(pA0, 8); PA_EXP4(pA0, 12); PA_EXP4(pA1, 0); PA_EXP4(pA1, 4); PA_EXP4(pA1, 8); PA_EXP4(pA1, 12);
    PA_SB();
#pragma unroll
    for (int s = 0; s < 4; ++s) { const LAS unsigned char* kn_ = lds + K_OFF + KSLOT; PA_KEEP(kf[2 * s]); PA_KEEP(kf[2 * s + 1]); kf[2 * s] = *(const LAS bf16x8*)(kn_ + xo[s]); kf[2 * s + 1] = *(const LAS bf16x8*)(kn_ + xo[s] + 4096); }
    asm volatile("s_waitcnt vmcnt(%0) lgkmcnt(0)" :: "n"(NOPS) : "memory"); __builtin_amdgcn_s_barrier();
#define PA_C(r) (((r) & 3) + 8 * ((r) >> 2))
#define PA_FIN4(X, i, w, A, B) do { if (MASKED) { X[i] = __uint_as_float(__float_as_uint(X[i]) & bfe1(w, PA_C(i))); X[(i) + 1] = __uint_as_float(__float_as_uint(X[(i) + 1]) & bfe1(w, PA_C((i) + 1))); \
            X[(i) + 2] = __uint_as_float(__float_as_uint(X[(i) + 2]) & bfe1(w, PA_C((i) + 2))); X[(i) + 3] = __uint_as_float(__float_as_uint(X[(i) + 3]) & bfe1(w, PA_C((i) + 3))); } \
        sa_ = fadd_s(sa_, X[i]); sb_ = fadd_s(sb_, X[(i) + 1]); sa_ = fadd_s(sa_, X[(i) + 2]); sb_ = fadd_s(sb_, X[(i) + 3]); A = cvtpk(X[i], X[(i) + 1]); B = cvtpk(X[(i) + 2], X[(i) + 3]); } while (0)
#define PA_VLD(i, vb) do { PA_KEEP(vf[i]); vf[i] = *(const LAS bf16x8*)((vb) + xo[(i) & 3] + ((i) >> 2) * 4096); } while (0)
#define PA_GAPA(i, MFST, X, e, w, PW, A, B) do { PA_VLD(i, vb_); MFST; PA_KEEP(PW); PA_FIN4(X, e, w, PW.A, PW.B); PA_PIN(PW); PA_PIN(sa_); PA_PIN(sb_); PA_SB(); } while (0)
#define PA_MASKW(tt) u32x2 mw_ = {0u, 0u}; if (MASKED) mw_ = *(const LAS u32x2*)(lds + MSK_OFF + wave * 4096 + ((tt) & 3) * 1024 + r32 * 16 + ((tt) & 1) * 8); const unsigned w0_ = mw_.x >> (4 * hi), w1_ = mw_.y >> (4 * hi)
#define PA_PVB(j) __builtin_bit_cast(bf16x8, pw##j)
#define PA_STEP(C0, C1, P0, P1, tt) do { const int t_ = (tt); \
        { \
            const LAS unsigned char* vb_ = lds + V_OFF + ((t_ - 1) & 3) * VSLOT; PA_MASKW(t_ - 1); float sa_ = 0.f, sb_ = 0.f; \
            const f32x16 z16 = {0.f, 0.f, 0.f, 0.f, 0.f, 0.f, 0.f, 0.f, 0.f, 0.f, 0.f, 0.f, 0.f, 0.f, 0.f, 0.f}; \
            PA_SB(); \
            PA_GAPA(0, C0 = PA_MF(kf[0], qf[0], negm), P0, 0, w0_, pw0, x, y); \
            PA_GAPA(4, C1 = PA_MF(kf[1], qf[0], negm), P0, 4, w0_, pw0, z, w); \
            PA_GAPA(1, C0 = PA_MF(kf[2], qf[1], C0), P0, 8, w0_, pw1, x, y); \
            PA_GAPA(5, C1 = PA_MF(kf[3], qf[1], C1), P0, 12, w0_, pw1, z, w); \
            PA_GAPA(2, C0 = PA_MF(kf[4], qf[2], C0), P1, 0, w1_, pw2, x, y); \
            PA_GAPA(6, C1 = PA_MF(kf[5], qf[2], C1), P1, 4, w1_, pw2, z, w); \
            PA_GAPA(3, C0 = PA_MF(kf[6], qf[3], C0), P1, 8, w1_, pw3, x, y); \
            PA_GAPA(7, C1 = PA_MF(kf[7], qf[3], C1), P1, 12, w1_, pw3, z, w); \
            lsum += sa_ + sb_; \
            if (t_ + 2 < nt) { PA_DM(t_ + 2); PA_DV(t_ + 2); } if (t_ + 3 < nt) PA_DK(t_ + 3); \
            PA_SB(); \
            asm volatile("s_nop 3" : "+v"(C0), "+v"(C1));     \
            _Pragma("unroll") for (int i = 0; i < 8; ++i) PA_KEEP(kf[i]); _Pragma("unroll") for (int i = 0; i < 4; ++i) PA_KEEP(qf[i]);     \
            PA_BIAS(C0, C1, t_); \
            { float rm_; PA_ROWMAX(rm_, C0, C1); resc = false; \
              if (__any(rm_ > 8.f)) { const float dl_ = fmaxf(rm_, 0.f), f_ = __builtin_amdgcn_exp2f(-dl_); lsum *= f_; if (hi == 0) wsf[r32] = f_; resc = true; \
                  _Pragma("unroll") for (int r = 0; r < 16; ++r) { C0[r] -= dl_; C1[r] -= dl_; negm[r] -= dl_; } } } \
            PA_SB(); \
            o[0] = PA_MF(PA_PVB(0), vf[0], o[0]); PA_EXP4(C0, 0); PA_SB(); \
            o[1] = PA_MF(PA_PVB(0), vf[4], o[1]); PA_EXP4(C0, 4); PA_SB(); \
            if (t_ + 1 < nt) PA_KLD(0, t_ + 1); o[0] = PA_MF(PA_PVB(1), vf[1], o[0]); PA_EXP4(C0, 8); PA_SB(); \
            if (t_ + 1 < nt) PA_KLD(1, t_ + 1); o[1] = PA_MF(PA_PVB(1), vf[5], o[1]); PA_EXP4(C0, 12); PA_SB(); \
            if (t_ + 1 < nt) PA_KLD(2, t_ + 1); o[0] = PA_MF(PA_PVB(2), vf[2], o[0]); PA_EXP4(C1, 0); PA_SB(); \
            if (t_ + 1 < nt) PA_KLD(3, t_ + 1); o[1] = PA_MF(PA_PVB(2), vf[6], o[1]); PA_EXP4(C1, 4); PA_SB(); \
            o[0] = PA_MF(PA_PVB(3), vf[3], o[0]); PA_EXP4(C1, 8); PA_SB(); \
            o[1] = PA_MF(PA_PVB(3), vf[7], o[1]); PA_EXP4(C1, 12); PA_SB(); \
        } \
        if (t_ + 3 < nt) asm volatile("s_waitcnt vmcnt(%0) lgkmcnt(0)" :: "n"(NOPS) : "memory"); \
        else if (t_ + 2 < nt) asm volatile("s_waitcnt vmcnt(%0) lgkmcnt(0)" :: "n"(NOPS - 1) : "memory"); \
        else asm volatile("s_waitcnt vmcnt(0) lgkmcnt(0)" ::: "memory"); \
        __builtin_amdgcn_s_barrier(); \
        if (resc) { resc = false; _Pragma("unroll") for (int r = 0; r < 16; ++r) { const float fr_ = wsf[crow(r, hi)]; o[0][r] *= fr_; o[1][r] *= fr_; } LDS_WAIT(); } \
    } while (0)
#define PA_DRAIN(P0, P1, tt) do { const LAS unsigned char* vb_ = lds + V_OFF + ((tt) & 3) * VSLOT; PA_MASKW(tt); float sa_ = 0.f, sb_ = 0.f; \
        PA_MFMA_DONE(o[0], o[1]); PA_SB(); \
        _Pragma("unroll") for (int i = 0; i < 8; ++i) PA_VLD(i, vb_); \
        asm volatile("s_waitcnt lgkmcnt(0)\n\ts_barrier" : "+v"(vf[0]), "+v"(vf[1]), "+v"(vf[2]), "+v"(vf[3]), "+v"(vf[4]), "+v"(vf[5]), "+v"(vf[6]), "+v"(vf[7]) :: "memory");     \
        PA_KEEP(pw0); PA_KEEP(pw1); PA_KEEP(pw2); PA_KEEP(pw3); \
        PA_FIN4(P0, 0, w0_, pw0.x, pw0.y); PA_FIN4(P0, 4, w0_, pw0.z, pw0.w); PA_FIN4(P0, 8, w0_, pw1.x, pw1.y); PA_FIN4(P0, 12, w0_, pw1.z, pw1.w); \
        PA_FIN4(P1, 0, w1_, pw2.x, pw2.y); PA_FIN4(P1, 4, w1_, pw2.z, pw2.w); PA_FIN4(P1, 8, w1_, pw3.x, pw3.y); PA_FIN4(P1, 12, w1_, pw3.z, pw3.w); \
        lsum += sa_ + sb_; PA_SB(); \
        o[0] = PA_MF(PA_PVB(0), vf[0], o[0]); o[1] = PA_MF(PA_PVB(0), vf[4], o[1]); o[0] = PA_MF(PA_PVB(1), vf[1], o[0]); o[1] = PA_MF(PA_PVB(1), vf[5], o[1]); \
        o[0] = PA_MF(PA_PVB(2), vf[2], o[0]); o[1] = PA_MF(PA_PVB(2), vf[6], o[1]); o[0] = PA_MF(PA_PVB(3), vf[3], o[0]); o[1] = PA_MF(PA_PVB(3), vf[7], o[1]); PA_SB(); \
        PA_MFMA_DONE(o[0], o[1]); PA_SB();     \
        PA_KEEP(pw0); PA_KEEP(pw1); PA_KEEP(pw2); PA_KEEP(pw3); _Pragma("unroll") for (int i = 0; i < 8; ++i) PA_KEEP(vf[i]); } while (0)
    int t = 1;
    for (; t + 1 < nt; t += 2) { PA_STEP(pB0, pB1, pA0, pA1, t); PA_STEP(pA0, pA1, pB0, pB1, t + 1); }
    PA_STEP(pB0, pB1, pA0, pA1, nt - 1);
    PA_DRAIN(pB0, pB1, nt - 1);
#undef PA_DK
#undef PA_DV
#undef PA_DM
#undef PA_KLD
#undef PA_BIAS
#undef PA_ROWMAX
#undef PA_EXP4
#undef PA_C
#undef PA_FIN4
#undef PA_VLD
#undef PA_GAPA
#undef PA_MASKW
#undef PA_PVB
#undef PA_STEP
#undef PA_DRAIN
    lsum = swap_sum(lsum);
    if (hi == 0) wsf[r32] = __builtin_amdgcn_rcpf(lsum);
    LDS_WAIT();
#pragma unroll
    for (int r = 0; r < 16; ++r) { const float fr = wsf[crow(r, hi)]; o[0][r] *= fr; o[1][r] *= fr; }
    LDS_WAIT();
}
#undef PA_SB
#undef PA_PIN
#undef PA_KEEP
#undef PA_MF
template <int DV>
__device__ __forceinline__ void store_tile(const f32x16 (&o)[DV / 32], bf16* O, LAS unsigned char* lds, int wave, int lane) {
    asm volatile("" : "+v"(lane));
    const int r32 = lane & 31, hi = lane >> 5;
    LAS bf16* stg = (LAS bf16*)(lds + OST_OFF + wave * 8192);
#pragma unroll
    for (int d0 = 0; d0 < DV / 32; ++d0)
#pragma unroll
        for (int r = 0; r < 16; ++r) stg[crow(r, hi) * DV + 32 * d0 + r32] = (bf16)f2bf(o[d0][r]);
    LDS_WAIT();
    constexpr int CPR = DV / 8;
#pragma unroll
    for (int i = 0; i < 32 * CPR / 64; ++i) { const int id = i * 64 + lane, row = id / CPR, ch = id % CPR;
        const v4u v = *(const LAS v4u*)(stg + row * DV + ch * 8); *(v4u*)(O + (size_t)row * 1024 + ch * 8) = v; }
    LDS_WAIT();
}
}

__device__ __forceinline__ void dsa_unit(const Ptrs& P, const LAS float* biasT, int b, int h, int qb, LAS unsigned char* lds, int tid, int wave, int lane) {
    asm volatile("" : "+v"(lane));
    const int q0 = 256 * qb, qpos = q0 + 32 * wave + (lane & 31);
    att::f32x16 o[2];
    att::attn_pass_p64<true>(o, P.QO + (size_t)b * SEQ * 1024 + h * 64, P.KK + (size_t)b * SEQ * 1024 + h * 64, P.VT + (size_t)(h * 64) * M + (size_t)b * SEQ,
                             P.MASK + (size_t)(b * SEQ) * 128, biasT + h * BIAS_LD, q0, 4 * (qb + 1), lds, tid, wave, lane);
    att::store_tile<64>(o, P.MIX + (size_t)(b * SEQ + q0 + 32 * wave) * 1024 + h * 64, lds, wave, lane);
}
__device__ __forceinline__ void diff_unit(const Ptrs& P, const LAS float* biasT, const float* subln, float lam_full, float lam_init, int b, int hd, int qb, LAS unsigned char* lds, int tid, int wave, int lane) {
    asm volatile("" : "+v"(lane));
    const int q0 = 256 * qb, r32 = lane & 31;
    const bf16* Qb = P.QO + (size_t)b * SEQ * 1024 + 512 + hd * 128; const bf16* Kb = P.KK + (size_t)b * SEQ * 1024 + 512 + hd * 128; const bf16* Vb = P.VT + (size_t)(512 + hd * 128) * M + (size_t)b * SEQ;
    att::f32x16 o[4];
    att::attn_pass<128, false>(o, Qb, Kb, Vb, nullptr, biasT + (8 + hd) * BIAS_LD, q0, 4 * (qb + 1), lds, tid, wave, lane);
    bf16* Ow = P.MIX + (size_t)(b * SEQ + q0 + 32 * wave) * 1024 + 512 + hd * 128;
    att::store_tile<128>(o, Ow, lds, wave, lane);
    att::attn_pass<128, false>(o, Qb + 64, Kb + 64, Vb, nullptr, biasT + (8 + hd) * BIAS_LD, q0, 4 * (qb + 1), lds, tid, wave, lane);
    LAS bf16* stg = (LAS bf16*)(lds + att::OST_OFF + wave * 8192);
    asm volatile("s_waitcnt vmcnt(0)" ::: "memory");
    { v4u pk[8];
#pragma unroll
      for (int i = 0; i < 8; ++i) { const int id = i * 64 + lane, row = id >> 4, ch = id & 15; pk[i] = *(const v4u*)(Ow + (size_t)row * 1024 + ch * 8); }
      asm volatile("s_waitcnt vmcnt(0)" ::: "memory");
#pragma unroll
      for (int i = 0; i < 8; ++i) { const int id = i * 64 + lane, row = id >> 4, ch = id & 15; *(LAS v4u*)(stg + row * 128 + ch * 8) = pk[i]; } }
    LDS_WAIT();
    float ss[16];
    { const int hi = lane >> 5;
#pragma unroll
      for (int r = 0; r < 16; ++r) { float s = 0.f;
#pragma unroll
        for (int d0 = 0; d0 < 4; ++d0) { const float d = bf2f(stg[att::crow(r, hi) * 128 + 32 * d0 + r32]) - lam_full * o[d0][r]; o[d0][r] = d; s += d * d; }
        ss[r] = s; } }
    LDS_WAIT();
    float g[4];
#pragma unroll
    for (int d0 = 0; d0 < 4; ++d0) g[d0] = subln[32 * d0 + r32] * (1.f - lam_init);
#pragma unroll
    for (int r = 0; r < 16; ++r) { float s = ss[r];
#pragma unroll
        for (int m = 1; m < 32; m <<= 1) s += __shfl_xor(s, m);
        const float rn = __builtin_amdgcn_rsqf(s * (1.f / 128.f) + 1e-6f);
#pragma unroll
        for (int d0 = 0; d0 < 4; ++d0) o[d0][r] *= rn * g[d0]; }
    att::store_tile<128>(o, P.MIX + (size_t)(b * SEQ + q0 + 32 * wave) * 1024 + 512 + hd * 128, lds, wave, lane);
}
__device__ __forceinline__ void attn_phase(const Ptrs& P, const LAS float* biasT, const float* subln, float lam_full, float lam_init, LAS unsigned char* lds, int bid, int G, int tid, int wave, int lane) {
    for (int vb = bid; vb < 256; vb += G) {
        const int vcu = (vb & 7) * 32 + (vb >> 3), g = vcu >> 2, k = vcu & 3;
        for (int j = 0; j < 2; ++j) { const int bh = 2 * g + j;
            for (int i = 0; i < 4; ++i) { const int qb = (i == 0) ? 15 - k : (i == 1) ? k : (i == 2) ? 11 - k : 4 + k; dsa_unit(P, biasT, bh >> 3, bh & 7, qb, lds, tid, wave, lane); } }
        for (int i = 0; i < 4; ++i) { const int qb = (i == 0) ? 15 - k : (i == 1) ? k : (i == 2) ? 11 - k : 4 + k; diff_unit(P, biasT, subln, lam_full, lam_init, g >> 2, g & 3, qb, lds, tid, wave, lane); }
    }
}

struct Args { const float* in[12]; float* out; unsigned char* ws; int ph_lo, ph_hi; };
__global__ void __launch_bounds__(NWAVES * 64, 2) fwd_kernel(Args args) {
    extern __shared__ __attribute__((aligned(16))) unsigned char lds_raw[];
    LAS unsigned char* lds = (LAS unsigned char*)lds_raw;
    volatile LAS unsigned* MISC = (volatile LAS unsigned*)(lds + MISC_OFF);
    const int tid = threadIdx.x;
#define ENTER() int tidl_ = threadIdx.x; asm volatile("" : "+v"(tidl_)); int bid_ = blockIdx.x, G = gridDim.x; asm volatile("" : "+s"(bid_), "+s"(G)); \
    const int lane = tidl_ & 63, wave = __builtin_amdgcn_readfirstlane(tidl_ >> 6), gw = bid_ * NWAVES + wave, NGW = G * NWAVES; (void)lane; (void)gw; (void)NGW; \
    LAS float* sc = (LAS float*)(lds + RING_OFF + wave * 16384); LAS float* qs = (LAS float*)(lds + WSCR_OFF + wave * 2048); const LAS float* biasT = (const LAS float*)(lds + BIAS_OFF); (void)sc; (void)qs; (void)biasT;
    typedef const __attribute__((address_space(4))) Args* KArgs;
    KArgs kargs = (KArgs)__builtin_amdgcn_kernarg_segment_ptr();
#define MKP() Ptrs P; { KArgs ka_ = kargs; asm volatile("" : "+s"(ka_)); unsigned char* ws = ka_->ws; \
    P.x = ka_->in[0]; P.attn_norm = ka_->in[1]; P.w_in = ka_->in[2]; P.diff_lambda = ka_->in[3]; P.diff_subln = ka_->in[4]; P.w_out = ka_->in[5]; P.ffn_norm = ka_->in[6]; \
    P.w_gate = ka_->in[7]; P.w_up = ka_->in[8]; P.w_down = ka_->in[9]; P.rel_bias = ka_->in[10]; P.final_norm = ka_->in[11]; P.out = ka_->out; \
    P.WIN = (bf16*)(ws + WS_WIN); P.WOUT = (bf16*)(ws + WS_WOUT); P.WGU = (bf16*)(ws + WS_WGU); P.WDN = (bf16*)(ws + WS_WDN); P.IK = (bf16*)(ws + WS_IK); \
    P.XB = (bf16*)(ws + WS_XB); P.QO = (bf16*)(ws + WS_QO); P.KK = (bf16*)(ws + WS_KK); P.VT = (bf16*)(ws + WS_VT); P.IQ = (bf16*)(ws + WS_IQ); P.ACT = (bf16*)(ws + WS_ACT); P.MIX = (bf16*)(ws + WS_MIX); \
    P.SS = (float*)(ws + WS_SS); P.IW = (float*)(ws + WS_IW); P.MASK = (unsigned*)(ws + WS_MASK); }
    gu32* ctl = (gu32*)(kargs->ws + WS_CTL);
    for (int u = tid; u < (LDS_BYTES - MISC_OFF) / 4; u += NWAVES * 64) ((LAS unsigned*)(lds + MISC_OFF))[u] = 0u;
    { MKP(); ENTER(); LAS float* bt = (LAS float*)(lds + BIAS_OFF);
      for (int i = tid; i < 12 * BIAS_LD; i += NWAVES * 64) { const int h = i / BIAS_LD, e = i % BIAS_LD; float v = 0.f;
          if (e == 0) v = -INFINITY; else if (e <= 128) v = (P.rel_bias[(int)T5_BUCKET[e - 1] * 12 + h] - P.rel_bias[31 * 12 + h]) * 1.4426950408889634f;
          bt[i] = v; } }
    __syncthreads();
    XcdBarrier bar; bar.bar = (unsigned*)(ctl + CW_BAR); bar.x = 0; bar.st = nullptr;
    if (!MK_PER_PHASE) bar = xcd_barrier_post((unsigned*)(ctl + CW_BAR), MISC + 8);
    const int lo = kargs->ph_lo, hi = kargs->ph_hi;
#define IN(k) (lo <= (k) && (k) < hi)
#define SEAM(k) do { if (IN(k) && IN((k) + 1)) xcd_barrier(bar); } while (0)

    if (IN(0)) { MKP(); ENTER(); prologue(P, lds, gw, NGW, wave, lane); }
    SEAM(0);
    for (int l = 0; l < DEPTH; ++l) {
        const int p0 = 1 + 6 * l;
        if (IN(p0)) {
            MKP(); ENTER();
            { pg8::Gemm g{P.XB, P.WIN + (size_t)l * NIN * DM, M, NIN_MAIN, DM}; pg8::StaticOrder S; S.init(M, NIN_MAIN, G, bid_);
              pg8::EpiInProj E{P.QO, P.KK, P.IQ, P.IK, P.IW, P.SS};
              pg8::gemm_phase<pg8::EpiInProj, pg8::StaticOrder, true, true>(lds + RING_OFF, g, S, E); }
            { pg8::Gemm g{P.WIN + ((size_t)l * NIN + NIN_MAIN) * DM, P.XB, NIN_V, M, DM}; pg8::StaticOrder S; S.init(NIN_V, M, G, bid_);
              pg8::EpiVT E{P.VT, P.SS};
              pg8::gemm_phase<pg8::EpiVT, pg8::StaticOrder, true, true>(lds + RING_OFF, g, S, E); }
        }
        SEAM(p0);
        if (IN(p0 + 1)) {
            MKP(); ENTER();
            idx::idx_phase<0>(P, lds, bid_, G, tidl_, wave, lane);
            if (PROBE_IDX > 1) idx::idx_phase<PROBE_IDX - 1>(P, lds, bid_, G, tidl_, wave, lane);
        }
        SEAM(p0 + 1);
        if (IN(p0 + 2)) {
            MKP(); ENTER();
            const float lam_init = 0.8f - 0.6f * __expf(-0.3f * (float)l);
            const float* lam = P.diff_lambda + l * 256;
            const float lam_full = __expf(wave_sum(lam[lane] * lam[64 + lane])) - __expf(wave_sum(lam[128 + lane] * lam[192 + lane])) + lam_init;
            for (int rep = 0; rep < PROBE_ATT; ++rep) attn_phase(P, biasT, P.diff_subln + l * 128, lam_full, lam_init, lds, bid_, G, tidl_, wave, lane);
        }
        SEAM(p0 + 2);
        if (IN(p0 + 3)) {
            MKP(); ENTER();
            pg8::Gemm g{P.MIX, P.WOUT + (size_t)l * DM * DM, M, DM, DM}; pg8::StaticOrder S; S.init(M, DM, G, bid_);
            pg8::EpiRes E{l == 0 ? P.x : nullptr, P.XB, P.SS};
            pg8::gemm_phase<pg8::EpiRes, pg8::StaticOrder, true, true>(lds + RING_OFF, g, S, E);
        }
        SEAM(p0 + 3);
        if (IN(p0 + 4)) {
            MKP(); ENTER();
            pg8::Gemm g{P.XB, P.WGU + (size_t)l * NGU * DM, M, NGU, DM}; pg8::StaticOrder S; S.init(M, NGU, G, bid_);
            pg8::EpiGateUp E{P.ACT, P.SS};
            for (int rep = 0; rep < PROBE_GU; ++rep) pg8::gemm_phase<pg8::EpiGateUp, pg8::StaticOrder, true, true>(lds + RING_OFF, g, S, E);
        }
        SEAM(p0 + 4);
        if (IN(p0 + 5)) {
            MKP(); ENTER();
            pg8::Gemm g{P.ACT, P.WDN + (size_t)l * DM * DFF, M, DM, DFF}; pg8::StaticOrder S; S.init(M, DM, G, bid_);
            pg8::EpiRes E{nullptr, P.XB, P.SS};
            pg8::gemm_phase<pg8::EpiRes, pg8::StaticOrder, true, true>(lds + RING_OFF, g, S, E);
        }
        SEAM(p0 + 5);
    }
    if (IN(NPH - 1)) { MKP(); ENTER(); final_norm_phase(P, gw, NGW, lane); }
#undef IN
#undef MKP
#undef ENTER
#undef SEAM
}

extern "C" void kernel_launch(void* const* d_in, const int* in_sizes, int n_in, void* d_out, int out_size, void* d_ws, size_t ws_size, hipStream_t stream) {
    static int grid = 0;
    if (grid == 0) {
        if (n_in != 12 || in_sizes[0] != M * DM || out_size != M * DM || ws_size < WS_END) { fprintf(stderr, "kernel_launch: unexpected shapes (n_in %d, in0 %d, out %d, ws %zu); nothing launched\n", n_in, n_in > 0 ? in_sizes[0] : -1, out_size, ws_size); grid = -1; return; }
        int dev = 0, cus = 0, per_cu = 0;
        if (hipGetDevice(&dev) != hipSuccess || hipDeviceGetAttribute(&cus, hipDeviceAttributeMultiprocessorCount, dev) != hipSuccess) { grid = -1; return; }
        if (hipFuncSetAttribute((const void*)fwd_kernel, hipFuncAttributeMaxDynamicSharedMemorySize, LDS_BYTES) != hipSuccess) { fprintf(stderr, "kernel_launch: hipFuncSetAttribute failed\n"); grid = -1; return; }
        if (hipOccupancyMaxActiveBlocksPerMultiprocessor(&per_cu, (const void*)fwd_kernel, NWAVES * 64, LDS_BYTES) != hipSuccess || per_cu < 1)
            fprintf(stderr, "kernel_launch: note: occupancy query reports %d workgroups per CU\n", per_cu);
        (void)hipGetLastError();
        grid = cus;
    }
    if (grid < 0) return;
    if (hipMemsetAsync((char*)d_ws + WS_CTL, 0, CTL_ZERO_BYTES, stream) != hipSuccess) return;
    Args a{};
    for (int i = 0; i < 12; ++i) a.in[i] = (const float*)d_in[i];
    a.out = (float*)d_out; a.ws = (unsigned char*)d_ws;
#if MK_PER_PHASE
    for (int k = 0; k < NPH; ++k) { a.ph_lo = k; a.ph_hi = k + 1; hipLaunchKernelGGL(fwd_kernel, dim3(grid), dim3(NWAVES * 64), LDS_BYTES, stream, a); }
#else
    a.ph_lo = 0; a.ph_hi = NPH;
    hipLaunchKernelGGL(fwd_kernel, dim3(grid), dim3(NWAVES * 64), LDS_BYTES, stream, a);
#endif
    const hipError_t le = hipPeekAtLastError();
    if (le != hipSuccess) fprintf(stderr, "kernel_launch: launch failed: %s\n", hipGetErrorName(le));
}
```

```cpp
#include <hip/hip_runtime.h>
#include <cstdio>
#include <cstdint>
namespace pg8 {
#define PG8_LAS __attribute__((address_space(3)))
typedef unsigned short bf16_t;
typedef short bf16x8 __attribute__((ext_vector_type(8)));
typedef float f32x4 __attribute__((ext_vector_type(4)));
typedef unsigned u32x4 __attribute__((ext_vector_type(4)));
constexpr int BM = 256, BK = 64, HALF = 128, HTB = HALF * BK * 2  , STAGE_BYTES = 8 * HTB, NXCD = 8, WGM = 8;

__host__ __device__ __forceinline__ int lds_byte(int r, int c) { const int st = (r >> 4) * 2 + (c >> 5), rr = r & 15, cc = c & 31, ob = rr * 64 + cc * 2; return st * 1024 + (ob ^ (((ob >> 9) & 1) << 5)); }
__host__ __device__ __forceinline__ void stage_rc(int b, int& R, int& C) { const int st = b / 1024, sb = b % 1024, swz = sb ^ (((sb >> 9) & 1) << 5); R = (st >> 1) * 16 + swz / 64; C = (st & 1) * 32 + (swz % 64) / 2; }
__host__ __device__ __forceinline__ int perm32(int rho) { const int n = rho >> 4, i = rho & 15; return 8 * (i >> 2) + 4 * n + (i & 3); }

struct Unit { int pm, pn; };
struct Gemm { const bf16_t* A; const bf16_t* Bt; int M, N, K; };

struct StaticOrder {
    int nM, nN, nwg, G, c;
    __host__ __device__ void init(int M, int N, int G_, int c_) { nM = M / BM; nN = N / BM; nwg = nM * nN; G = G_; c = c_; }
    __host__ __device__ bool next(int i, Unit& u) const {
        const long L = (long)i * G + c; if (L >= nwg) return false;
        int wgid = (int)L; { const int q = nwg / NXCD, r = nwg % NXCD, xcd = wgid % NXCD, off = wgid / NXCD; wgid = (xcd < r ? xcd * (q + 1) : r * (q + 1) + (xcd - r) * q) + off; }
        const int nig = WGM * nN, gid = wgid / nig, fm = gid * WGM, gsz = (nM - fm) < WGM ? (nM - fm) : WGM;
        u.pm = fm + ((wgid % nig) % gsz); u.pn = (wgid % nig) / gsz; return true;
    }
    __device__ __forceinline__ void a_ready(const Unit&) const {}
    __device__ __forceinline__ void done(const Unit&) const {}
};

__device__ __forceinline__ unsigned cvt_pk_bf16(float lo, float hi) { unsigned r; asm volatile("v_cvt_pk_bf16_f32 %0, %1, %2" : "=v"(r) : "v"(lo), "v"(hi)); return r; }
typedef float f32x2 __attribute__((ext_vector_type(2)));
typedef float f32x2 __attribute__((ext_vector_type(2)));
typedef unsigned u32x2v __attribute__((ext_vector_type(2)));
constexpr float RMS_EPS = 1e-6f;
constexpr float QSCALE = 0.125f * 1.4426950408889634f;
__device__ __forceinline__ float row_rs(const float* SS, int row) {
    const f32x4* p = (const f32x4*)(SS + (size_t)row * 16); const f32x4 a = p[0], b = p[1], c = p[2], d = p[3];
    const float s = ((a[0] + a[1]) + (a[2] + a[3])) + ((b[0] + b[1]) + (b[2] + b[3])) + ((c[0] + c[1]) + (c[2] + c[3])) + ((d[0] + d[1]) + (d[2] + d[3]));
    return __builtin_amdgcn_rsqf(s * (1.f / 1024.f) + RMS_EPS);
}
constexpr int RS_LDS_OFF = 131072;
__device__ __forceinline__ const PG8_LAS float* stage_rs(const float* SS, int row0) {
    PG8_LAS float* rb = (PG8_LAS float*)(uintptr_t)RS_LDS_OFF;
    int tid = threadIdx.x; asm volatile("" : "+v"(tid));
    if (tid < 256) rb[tid] = row_rs(SS, row0 + tid);
    asm volatile("s_waitcnt lgkmcnt(0)\n\ts_barrier" ::: "memory");
    return rb;
}
struct EpiInProj {
    static constexpr bool PERM = true, AFTER_DRAIN = false;
    bf16_t *QO, *KK, *IQ, *IK; float* IW; const float* SS;
    __device__ __forceinline__ void operator()(const f32x4 (&acc)[2][2][4][2], const Unit& u, int wr, int wc, int fr, int fq) const {
        const int row0 = u.pm * BM + wr * 64 + fr, pn = u.pn, lr0 = wr * 64 + fr;
        const PG8_LAS float* rb = stage_rs(SS, u.pm * BM);
        if (pn < 10) {
            bf16_t* base; int ldc, colt; float sc = 1.f;
            if (pn < 4) { base = QO; ldc = 1024; colt = pn * 256; sc = QSCALE; }
            else if (pn < 8) { base = KK; ldc = 1024; colt = (pn - 4) * 256; }
            else { base = IQ; ldc = 512; colt = (pn - 8) * 256; }
            const int col0 = colt + wc * 32 + 8 * fq;
#pragma unroll
            for (int ai = 0; ai < 2; ++ai)
#pragma unroll
                for (int m = 0; m < 4; ++m) { bf16_t* rowp = base + (size_t)(row0 + ai * HALF + m * 16) * ldc + col0; const float s = rb[lr0 + ai * HALF + m * 16] * sc;
#pragma unroll
                    for (int bj = 0; bj < 2; ++bj) { const f32x4 v0 = acc[ai][bj][m][0] * s, v1 = acc[ai][bj][m][1] * s;
                        u32x4 w; w.x = cvt_pk_bf16(v0[0], v0[1]); w.y = cvt_pk_bf16(v0[2], v0[3]); w.z = cvt_pk_bf16(v1[0], v1[1]); w.w = cvt_pk_bf16(v1[2], v1[3]);
                        *(u32x4*)(rowp + bj * HALF) = w; }
                    }
        } else {
            const int c = wc * 32 + 8 * fq;
#pragma unroll
            for (int ai = 0; ai < 2; ++ai)
#pragma unroll
                for (int m = 0; m < 4; ++m) { const int row = row0 + ai * HALF + m * 16; const float s = rb[lr0 + ai * HALF + m * 16];
                    const f32x4 v0 = acc[ai][0][m][0] * s, v1 = acc[ai][0][m][1] * s;
                    if (c < 64) { u32x4 w; w.x = cvt_pk_bf16(v0[0], v0[1]); w.y = cvt_pk_bf16(v0[2], v0[3]); w.z = cvt_pk_bf16(v1[0], v1[1]); w.w = cvt_pk_bf16(v1[2], v1[3]);
                        *(u32x4*)(IK + (size_t)row * 64 + c) = w; }
                    else if (c == 64) { *(f32x4*)(IW + (size_t)row * 8) = v0; *(f32x4*)(IW + (size_t)row * 8 + 4) = v1; }
                    }
        }
    }
};
struct EpiVT {
    static constexpr bool PERM = true, AFTER_DRAIN = false;
    bf16_t* VT; const float* SS;
    __device__ __forceinline__ void operator()(const f32x4 (&acc)[2][2][4][2], const Unit& u, int wr, int wc, int fr, int fq) const {
        const int row0 = u.pm * BM + wr * 64 + fr, col0 = u.pn * BM + wc * 32 + 8 * fq;
        const PG8_LAS float* rb = stage_rs(SS, u.pn * BM);
        const int pos0 = (col0 & ~15) + ((col0 & 8) ? 4 : 0);
#pragma unroll
        for (int bj = 0; bj < 2; ++bj) { float rs[8];
#pragma unroll
            for (int i = 0; i < 8; ++i) rs[i] = rb[wc * 32 + 8 * fq + bj * HALF + i];
#pragma unroll
            for (int ai = 0; ai < 2; ++ai)
#pragma unroll
                for (int m = 0; m < 4; ++m) { const f32x4 v0 = acc[ai][bj][m][0], v1 = acc[ai][bj][m][1];
                    u32x2v w0, w1; w0.x = cvt_pk_bf16(v0[0] * rs[0], v0[1] * rs[1]); w0.y = cvt_pk_bf16(v0[2] * rs[2], v0[3] * rs[3]); w1.x = cvt_pk_bf16(v1[0] * rs[4], v1[1] * rs[5]); w1.y = cvt_pk_bf16(v1[2] * rs[6], v1[3] * rs[7]);
                    bf16_t* p = VT + (size_t)(row0 + ai * HALF + m * 16) * 65536 + pos0 + bj * HALF;
                    *(u32x2v*)p = w0; *(u32x2v*)(p + 8) = w1; }
            }
    }
};
struct EpiRes {
    static constexpr bool PERM = true, AFTER_DRAIN = false;
    const float* Xf32; bf16_t* XB; float* SS;
    __device__ __forceinline__ void operator()(const f32x4 (&acc)[2][2][4][2], const Unit& u, int wr, int wc, int fr, int fq) const {
        const int row0 = u.pm * BM + wr * 64 + fr, col0 = u.pn * BM + wc * 32 + 8 * fq;
        if (Xf32) {
#pragma unroll
            for (int ai = 0; ai < 2; ++ai)
#pragma unroll
                for (int m = 0; m < 4; ++m) { const int row = row0 + ai * HALF + m * 16; const size_t off = (size_t)row * 1024 + col0; float ss = 0.f;
#pragma unroll
                    for (int bj = 0; bj < 2; ++bj) { const f32x4 x0 = *(const f32x4*)(Xf32 + off + bj * HALF), x1 = *(const f32x4*)(Xf32 + off + bj * HALF + 4);
                        const f32x4 v0 = acc[ai][bj][m][0] + x0, v1 = acc[ai][bj][m][1] + x1;
                        u32x4 w; w.x = cvt_pk_bf16(v0[0], v0[1]); w.y = cvt_pk_bf16(v0[2], v0[3]); w.z = cvt_pk_bf16(v1[0], v1[1]); w.w = cvt_pk_bf16(v1[2], v1[3]);
                        *(u32x4*)(XB + off + bj * HALF) = w;
                        ss += (v0[0] * v0[0] + v0[1] * v0[1]) + (v0[2] * v0[2] + v0[3] * v0[3]) + (v1[0] * v1[0] + v1[1] * v1[1]) + (v1[2] * v1[2] + v1[3] * v1[3]); }
                    ss += __shfl_xor(ss, 16); ss += __shfl_xor(ss, 32);
                    if (fq == 0) SS[(size_t)row * 16 + u.pn * 4 + wc] = ss;
                    asm volatile("" ::: "memory"); }
            return;
        }
#pragma unroll
        for (int ai = 0; ai < 2; ++ai) { u32x4 xb[4][2];
#pragma unroll
            for (int m = 0; m < 4; ++m)
#pragma unroll
                for (int bj = 0; bj < 2; ++bj) xb[m][bj] = *(const u32x4*)(XB + (size_t)(row0 + ai * HALF + m * 16) * 1024 + col0 + bj * HALF);
#pragma unroll
            for (int m = 0; m < 4; ++m) { const int row = row0 + ai * HALF + m * 16; const size_t off = (size_t)row * 1024 + col0; float ss = 0.f;
#pragma unroll
                for (int bj = 0; bj < 2; ++bj) { const u32x4 x = xb[m][bj];
                    const f32x4 x0 = (f32x4){__builtin_bit_cast(float, x.x << 16), __builtin_bit_cast(float, x.x & 0xffff0000u), __builtin_bit_cast(float, x.y << 16), __builtin_bit_cast(float, x.y & 0xffff0000u)};
                    const f32x4 x1 = (f32x4){__builtin_bit_cast(float, x.z << 16), __builtin_bit_cast(float, x.z & 0xffff0000u), __builtin_bit_cast(float, x.w << 16), __builtin_bit_cast(float, x.w & 0xffff0000u)};
                    const f32x4 v0 = acc[ai][bj][m][0] + x0, v1 = acc[ai][bj][m][1] + x1;
                    u32x4 w; w.x = cvt_pk_bf16(v0[0], v0[1]); w.y = cvt_pk_bf16(v0[2], v0[3]); w.z = cvt_pk_bf16(v1[0], v1[1]); w.w = cvt_pk_bf16(v1[2], v1[3]);
                    *(u32x4*)(XB + off + bj * HALF) = w;
                    ss += (v0[0] * v0[0] + v0[1] * v0[1]) + (v0[2] * v0[2] + v0[3] * v0[3]) + (v1[0] * v1[0] + v1[1] * v1[1]) + (v1[2] * v1[2] + v1[3] * v1[3]); }
                ss += __shfl_xor(ss, 16); ss += __shfl_xor(ss, 32);
                if (fq == 0) SS[(size_t)row * 16 + u.pn * 4 + wc] = ss; }
            asm volatile("" ::: "memory"); }
    }
};
struct EpiGateUp {
    static constexpr bool PERM = true, AFTER_DRAIN = false;
    bf16_t* ACT; const float* SS;
    __device__ __forceinline__ void operator()(const f32x4 (&acc)[2][2][4][2], const Unit& u, int wr, int wc, int fr, int fq) const {
        const int row0 = u.pm * BM + wr * 64 + fr, col0 = u.pn * HALF + wc * 32 + 8 * fq;
        const PG8_LAS float* rb = stage_rs(SS, u.pm * BM);
#pragma unroll
        for (int ai = 0; ai < 2; ++ai)
#pragma unroll
            for (int m = 0; m < 4; ++m) { const int row = row0 + ai * HALF + m * 16; const float s = rb[wr * 64 + fr + ai * HALF + m * 16];
                float a[8];
#pragma unroll
                for (int n = 0; n < 2; ++n)
#pragma unroll
                    for (int i = 0; i < 4; ++i) { const float g = acc[ai][0][m][n][i] * s, up = acc[ai][1][m][n][i] * s;
                        a[4 * n + i] = g * __builtin_amdgcn_rcpf(1.f + __builtin_amdgcn_exp2f(-1.4426950408889634f * g)) * up; }
                u32x4 w; w.x = cvt_pk_bf16(a[0], a[1]); w.y = cvt_pk_bf16(a[2], a[3]); w.z = cvt_pk_bf16(a[4], a[5]); w.w = cvt_pk_bf16(a[6], a[7]);
                *(u32x4*)(ACT + (size_t)row * 2816 + col0) = w; }
    }
};

template <class Epi, class Sched, bool ALIGN_EPI = false, bool SP2 = false>
__device__ __forceinline__ void gemm_phase(PG8_LAS unsigned char* lds, const Gemm g, const Sched& S, const Epi& E) {
    int tid_l = threadIdx.x; asm volatile("" : "+v"(tid_l));
    const int tid = tid_l, wid = __builtin_amdgcn_readfirstlane(tid >> 6), lane = tid & 63, wr = wid >> 2, wc = wid & 3, fr = lane & 15, fq = lane >> 4;
    const int K = g.K, nt = K / BK;
    unsigned voffA[2], voffB[2];
#pragma unroll
    for (int i = 0; i < 2; ++i) { int R, C; stage_rc(tid * 16 + i * 8192, R, C); const int Rb = Epi::PERM ? ((R & ~31) + perm32(R & 31)) : R;
        voffA[i] = (unsigned)(R * K + C) * 2u; voffB[i] = (unsigned)(Rb * K + C) * 2u; }
    const size_t kstep = (size_t)(BK * 2);
    const size_t hstep = (size_t)HALF * K * 2;
    const size_t tstep = 2 * hstep;
    const unsigned ldsw = (unsigned)wid * 1024u;
    const int aoff = lds_byte(wr * 64 + fr, fq * 8), boff = lds_byte(wc * 32 + fr, fq * 8);
#define PG8_SA(b, h) (((b) * 2 + (h)) * HTB)
#define PG8_SB(b, h) ((4 + (b) * 2 + (h)) * HTB)
#define PG8_STAGE(bufoff, gbase, voff) do { const char* gb_ = (const char*)(gbase); asm volatile("" : "+s"(gb_)); _Pragma("unroll") for (int _i = 0; _i < 2; ++_i) { asm volatile("" : "+v"((voff)[_i])); \
        __builtin_amdgcn_global_load_lds((const unsigned*)(gb_ + (voff)[_i]), (PG8_LAS unsigned*)(lds + (bufoff) + ldsw + _i * 8192), 16, 0, 0); } } while (0)
#define PG8_LDA(dst, b, h) do { _Pragma("unroll") for (int m = 0; m < 4; ++m) _Pragma("unroll") for (int k = 0; k < 2; ++k) dst[m][k] = *(const PG8_LAS bf16x8*)(lds + PG8_SA(b, h) + aoff + m * 2048 + k * 1024); } while (0)
#define PG8_LDB(dst, b, h) do { _Pragma("unroll") for (int n = 0; n < 2; ++n) _Pragma("unroll") for (int k = 0; k < 2; ++k) dst[n][k] = *(const PG8_LAS bf16x8*)(lds + PG8_SB(b, h) + boff + n * 2048 + k * 1024); } while (0)
#define PG8_MMA(ai, bj, At, Bt) do { __builtin_amdgcn_s_setprio(1); _Pragma("unroll") for (int m = 0; m < 4; ++m) _Pragma("unroll") for (int n = 0; n < 2; ++n) _Pragma("unroll") for (int k = 0; k < 2; ++k) \
        acc[ai][bj][m][n] = __builtin_amdgcn_mfma_f32_16x16x32_bf16(Bt[n][k], At[m][k], acc[ai][bj][m][n], 0, 0, 0); __builtin_amdgcn_s_setprio(0); } while (0)
#define PG8_WAIT_V(n) asm volatile("s_waitcnt vmcnt(" #n ")" ::: "memory")
#define PG8_WAIT_L(n) asm volatile("s_waitcnt lgkmcnt(" #n ")" ::: "memory")
#define PG8_BAR __builtin_amdgcn_s_barrier()
#define PG8_SCHED __builtin_amdgcn_sched_barrier(0)
    Unit cur, nxt; int ui = 0;
    if (!S.next(0, cur)) return;
    f32x4 acc[2][2][4][2];
#pragma unroll
    for (int a = 0; a < 2; ++a)
#pragma unroll
        for (int b = 0; b < 2; ++b)
#pragma unroll
            for (int m = 0; m < 4; ++m)
#pragma unroll
                for (int n = 0; n < 2; ++n) acc[a][b][m][n] = (f32x4){0.f, 0.f, 0.f, 0.f};
    bf16x8 At[4][2], B0[2][2], B1[2][2];
    const char* cA = (const char*)g.A + (size_t)cur.pm * tstep; const char* cB = (const char*)g.Bt + (size_t)cur.pn * tstep;
    S.a_ready(cur);
    if constexpr (SP2) {
        PG8_STAGE(PG8_SB(0, 0), cB, voffB); PG8_STAGE(PG8_SB(0, 1), cB + hstep, voffB); PG8_STAGE(PG8_SA(0, 0), cA, voffA); PG8_STAGE(PG8_SA(0, 1), cA + hstep, voffA);
        if (wr == 1) PG8_BAR;
        PG8_WAIT_V(2); PG8_BAR;
        PG8_STAGE(PG8_SB(1, 0), cB + kstep, voffB); PG8_STAGE(PG8_SA(1, 0), cA + kstep, voffA); PG8_STAGE(PG8_SB(1, 1), cB + hstep + kstep, voffB);
        PG8_WAIT_V(6); PG8_BAR;
    } else {
        PG8_STAGE(PG8_SB(0, 0), cB, voffB); PG8_STAGE(PG8_SA(0, 0), cA, voffA); PG8_STAGE(PG8_SB(0, 1), cB + hstep, voffB); PG8_STAGE(PG8_SA(0, 1), cA + hstep, voffA);
        if (wr == 1) PG8_BAR;
        PG8_WAIT_V(4); PG8_BAR;
        PG8_STAGE(PG8_SB(1, 0), cB + kstep, voffB); PG8_STAGE(PG8_SA(1, 0), cA + kstep, voffA); PG8_STAGE(PG8_SB(1, 1), cB + hstep + kstep, voffB);
        PG8_WAIT_V(6); PG8_BAR;
    }
    for (;;) {
        const bool has_next = S.next(ui + 1, nxt);
        const char* nA = has_next ? (const char*)g.A + (size_t)nxt.pm * tstep : cA; const char* nB = has_next ? (const char*)g.Bt + (size_t)nxt.pn * tstep : cB;
        for (int t = 0; t < nt; t += 2) {
            const bool last = (t == nt - 2);
            const char* a1 = cA + (size_t)(t + 1) * kstep;
            const char* a2 = last ? nA : cA + (size_t)(t + 2) * kstep; const char* b2 = last ? nB : cB + (size_t)(t + 2) * kstep;
            const char* a3 = a2 + kstep; const char* b3 = b2 + kstep;
            if (last && has_next) S.a_ready(nxt);
            if constexpr (SP2) {
            PG8_LDB(B0, 0, 0); PG8_LDB(B1, 0, 1); PG8_SCHED; PG8_LDA(At, 0, 0); PG8_STAGE(PG8_SA(1, 1), a1 + hstep, voffA);
            PG8_WAIT_V(8); PG8_WAIT_L(0); PG8_BAR; PG8_MMA(0, 0, At, B0); PG8_MMA(0, 1, At, B1); PG8_BAR; PG8_SCHED;
            PG8_LDA(At, 0, 1); PG8_STAGE(PG8_SB(0, 0), b2, voffB); PG8_STAGE(PG8_SB(0, 1), b2 + hstep, voffB); PG8_STAGE(PG8_SA(0, 0), a2, voffA);
            PG8_WAIT_V(8); PG8_WAIT_L(0); PG8_BAR; PG8_MMA(1, 0, At, B0); PG8_MMA(1, 1, At, B1); PG8_BAR; PG8_SCHED;
            PG8_LDB(B0, 1, 0); PG8_LDB(B1, 1, 1); PG8_SCHED; PG8_LDA(At, 1, 0); PG8_STAGE(PG8_SA(0, 1), a2 + hstep, voffA);
            PG8_WAIT_V(8); PG8_WAIT_L(0); PG8_BAR; PG8_MMA(0, 0, At, B0); PG8_MMA(0, 1, At, B1); PG8_BAR; PG8_SCHED;
            PG8_LDA(At, 1, 1); PG8_STAGE(PG8_SB(1, 0), b3, voffB); PG8_STAGE(PG8_SB(1, 1), b3 + hstep, voffB); PG8_STAGE(PG8_SA(1, 0), a3, voffA);
            PG8_WAIT_V(8); PG8_WAIT_L(0); PG8_BAR; PG8_MMA(1, 0, At, B0); PG8_MMA(1, 1, At, B1); PG8_BAR; PG8_SCHED;
            } else {
            PG8_LDB(B0, 0, 0); PG8_SCHED; PG8_LDA(At, 0, 0); PG8_STAGE(PG8_SA(1, 1), a1 + hstep, voffA);
            PG8_WAIT_L(8); PG8_BAR; PG8_WAIT_L(0); PG8_MMA(0, 0, At, B0); PG8_BAR; PG8_SCHED;
            PG8_LDB(B1, 0, 1); PG8_STAGE(PG8_SB(0, 0), b2, voffB);
            PG8_BAR; PG8_WAIT_L(0); PG8_MMA(0, 1, At, B1); PG8_BAR;
            PG8_LDA(At, 0, 1); PG8_STAGE(PG8_SA(0, 0), a2, voffA);
            PG8_BAR; PG8_WAIT_L(0); PG8_MMA(1, 0, At, B0); PG8_BAR; PG8_SCHED;
            PG8_STAGE(PG8_SB(0, 1), b2 + hstep, voffB);
            PG8_WAIT_V(6); PG8_BAR; PG8_MMA(1, 1, At, B1); PG8_BAR;
            PG8_LDB(B0, 1, 0); PG8_SCHED; PG8_LDA(At, 1, 0); PG8_STAGE(PG8_SA(0, 1), a2 + hstep, voffA);
            PG8_WAIT_L(8); PG8_BAR; PG8_WAIT_L(0); PG8_MMA(0, 0, At, B0); PG8_BAR; PG8_SCHED;
            PG8_LDB(B1, 1, 1); PG8_STAGE(PG8_SB(1, 0), b3, voffB);
            PG8_BAR; PG8_WAIT_L(0); PG8_MMA(0, 1, At, B1); PG8_BAR;
            PG8_LDA(At, 1, 1); PG8_STAGE(PG8_SA(1, 0), a3, voffA);
            PG8_BAR; PG8_WAIT_L(0); PG8_MMA(1, 0, At, B0); PG8_BAR; PG8_SCHED;
            PG8_STAGE(PG8_SB(1, 1), b3 + hstep, voffB);
            PG8_WAIT_V(6); PG8_BAR; PG8_MMA(1, 1, At, B1); PG8_BAR;
            }
        }
        if constexpr (ALIGN_EPI) { if (wr == 0) PG8_BAR; }
        if constexpr (!Epi::AFTER_DRAIN) { E(acc, cur, wr, wc, fr, fq); S.done(cur); }
        if (!has_next) break;
#pragma unroll
        for (int a = 0; a < 2; ++a)
#pragma unroll
            for (int b = 0; b < 2; ++b)
#pragma unroll
                for (int m = 0; m < 4; ++m)
#pragma unroll
                    for (int n = 0; n < 2; ++n) acc[a][b][m][n] = (f32x4){0.f, 0.f, 0.f, 0.f};
        cur = nxt; cA = nA; cB = nB; ++ui;
        if constexpr (ALIGN_EPI) { if (wr == 1) PG8_BAR; }
    }
    PG8_WAIT_V(0);
    if constexpr (!ALIGN_EPI) { if (wr == 0) PG8_BAR; }
    PG8_BAR;
    if constexpr (Epi::AFTER_DRAIN) { E.fused(acc, cur, wr, wc, fr, fq, lds, wid, lane); S.done(cur); }
#undef PG8_SA
#undef PG8_SB
#undef PG8_STAGE
#undef PG8_LDA
#undef PG8_LDB
#undef PG8_MMA
#undef PG8_WAIT_V
#undef PG8_WAIT_L
#undef PG8_BAR
#undef PG8_SCHED
}
}
constexpr int NWAVES = 8;
constexpr int BATCH = 16, SEQ = 4096, DM = 1024, DEPTH = 4, M = BATCH * SEQ;
constexpr int IN_COLS = 3656, NIN = 3840, NIN_MAIN = 2816  , NIN_V = 1024  , DFF = 2816, NGU = 2 * DFF;
constexpr int NPH = 2 + 6 * DEPTH;
#ifndef PROBE_ATT
#define PROBE_ATT 1
#endif
#ifndef PROBE_GU
#define PROBE_GU 1
#endif
#ifndef PROBE_IDX
#define PROBE_IDX 1
#endif
#ifndef MK_PER_PHASE
#define MK_PER_PHASE 0
#endif
constexpr size_t MiB = 1u << 20;
constexpr size_t WS_CTL = 0, CTL_ZERO_BYTES = 1 * MiB;
constexpr size_t WS_WIN = 2 * MiB, WS_WOUT = 32 * MiB, WS_WGU = 40 * MiB, WS_WDN = 84 * MiB;
constexpr size_t WS_SS = 106 * MiB, WS_IW = 110 * MiB, WS_IK = 112 * MiB;
constexpr size_t WS_XB = 128 * MiB, WS_QO = 256 * MiB, WS_KK = 384 * MiB, WS_VT = 512 * MiB, WS_IQ = 640 * MiB, WS_MASK = 704 * MiB, WS_ACT = 384 * MiB, WS_MIX = 736 * MiB, WS_END = 864 * MiB;
static_assert(WS_WIN + (size_t)DEPTH * NIN * DM * 2 <= WS_WOUT && WS_WOUT + (size_t)DEPTH * DM * DM * 2 <= WS_WGU && WS_WGU + (size_t)DEPTH * NGU * DM * 2 <= WS_WDN && WS_WDN + (size_t)DEPTH * DM * DFF * 2 <= WS_SS, "weights map");
static_assert(WS_ACT + (size_t)M * DFF * 2 <= WS_MIX && WS_MASK + (size_t)M * 512 <= WS_MIX && WS_MIX + (size_t)M * 1024 * 2 <= WS_END && WS_IQ + (size_t)M * 512 * 2 <= WS_MASK && WS_KK + (size_t)M * 1024 * 2 <= WS_VT && WS_VT + (size_t)M * 1024 * 2 <= WS_IQ, "activation map");
constexpr int CW_BAR = 4096;
constexpr int RING_OFF = 0, RING_BYTES = 131072, WSCR_OFF = 131072  , BIAS_OFF = 147456  , BIAS_LD = 132, MISC_OFF = 154112, LDS_BYTES = 155648;

#define GAS __attribute__((address_space(1)))
#define LAS __attribute__((address_space(3)))
typedef unsigned short bf16;
typedef unsigned v4u __attribute__((ext_vector_type(4)));
typedef float f32x4 __attribute__((ext_vector_type(4)));
typedef GAS unsigned gu32;
#define LDS_WAIT() asm volatile("s_waitcnt lgkmcnt(0)" ::: "memory")
#define VM_WAIT() asm volatile("s_waitcnt vmcnt(0)" ::: "memory")
__device__ __forceinline__ unsigned f2bf(float f) { unsigned u = __builtin_bit_cast(unsigned, f); return (u + 0x7fffu + ((u >> 16) & 1u)) >> 16; }
__device__ __forceinline__ unsigned pk2(float lo, float hi) { return f2bf(lo) | (f2bf(hi) << 16); }
__device__ __forceinline__ float bf2f(unsigned h) { return __builtin_bit_cast(float, h << 16); }
__device__ __forceinline__ float bflo(unsigned w) { return __builtin_bit_cast(float, w << 16); }
__device__ __forceinline__ float bfhi(unsigned w) { return __builtin_bit_cast(float, w & 0xffff0000u); }
__device__ __forceinline__ float wave_sum(float v) {
#pragma unroll
    for (int o = 1; o < 64; o <<= 1) v += __shfl_xor(v, o);
    return v;
}
__device__ __forceinline__ int wave_sum_i(int v) {
#pragma unroll
    for (int o = 1; o < 64; o <<= 1) v += __shfl_xor(v, o);
    return v;
}
__device__ __forceinline__ float wave_max(float v) {
#pragma unroll
    for (int o = 1; o < 64; o <<= 1) v = fmaxf(v, __shfl_xor(v, o));
    return v;
}
__device__ __forceinline__ unsigned ukey(float f) { const unsigned b = __builtin_bit_cast(unsigned, f); return b ^ ((b >> 31) ? 0xFFFFFFFFu : 0x80000000u); }
__device__ const unsigned char T5_BUCKET[128] = {0, 1, 2, 3, 4, 5, 6, 7, 8, 9, 10, 11, 12, 13, 14, 15, 16, 16, 16, 17, 17, 18, 18, 18, 19, 19, 19, 20, 20, 20, 20, 21, 21, 21, 21, 22, 22, 22, 22, 22, 23, 23, 23, 23, 23, 23, 24, 24, 24, 24, 24, 24, 25, 25, 25, 25, 25, 25, 25, 26, 26, 26, 26, 26, 26, 26, 26, 27, 27, 27, 27, 27, 27, 27, 27, 27, 27, 28, 28, 28, 28, 28, 28, 28, 28, 28, 28, 29, 29, 29, 29, 29, 29, 29, 29, 29, 29, 29, 29, 30, 30, 30, 30, 30, 30, 30, 30, 30, 30, 30, 30, 30, 30, 31, 31, 31, 31, 31, 31, 31, 31, 31, 31, 31, 31, 31, 31, 31};
__device__ __forceinline__ const char* uni_ptr(const char* p) { const unsigned long long v = (unsigned long long)p; const unsigned lo = __builtin_amdgcn_readfirstlane((unsigned)v), hi = __builtin_amdgcn_readfirstlane((unsigned)(v >> 32)); return (const char*)(((unsigned long long)hi << 32) | lo); }
#define XB_TMO      128
#define XB_XCNT(j)  (256  + 64 * (j))
#define XB_XSUB(j)  (1280 + 64 * (j))
#define XB_XGEN(j)  (2304 + 64 * (j))
#define XB_TOP      3328
#define XB_TOPGEN   3392
#define XCD_BAR_WORDS 3456
#define XB_SPIN_CAP (1u << 18)

__device__ __forceinline__ unsigned xb_ld(unsigned* p)              { return __hip_atomic_load(p, __ATOMIC_RELAXED, __HIP_MEMORY_SCOPE_AGENT); }
__device__ __forceinline__ unsigned xb_add(unsigned* p, unsigned v) { return __hip_atomic_fetch_add(p, v, __ATOMIC_RELAXED, __HIP_MEMORY_SCOPE_AGENT); }
__device__ __forceinline__ unsigned xb_xcc_id() { return (unsigned)__builtin_amdgcn_s_getreg((3 << 11) | 20) & 0xFu; }
#define XB_SPIN(cond, bar) do { unsigned _sp = 0; while (cond) { __builtin_amdgcn_s_sleep(1); \
    if ((++_sp & 255u) == 0u) { if (xb_ld(&(bar)[XB_TMO])) break; if (_sp > XB_SPIN_CAP) { atomicAdd(&(bar)[XB_TMO], 1u); break; } } } } while (0)

struct XcdBarrier {
    unsigned* bar; unsigned x;
    volatile LAS unsigned* st;
};

__device__ __forceinline__ XcdBarrier xcd_barrier_post(unsigned* bar, volatile LAS unsigned* st) {
    XcdBarrier b; b.bar = bar; b.x = xb_xcc_id(); b.st = st;
    if (threadIdx.x == 0) (void)xb_add(&bar[XB_XCNT(b.x)], 1u);
    return b;
}
__device__ __forceinline__ void xcd_barrier_complete(unsigned* bar, unsigned x, unsigned& nloc, unsigned& nx) {
    const unsigned G = gridDim.x * gridDim.y * gridDim.z;
    unsigned sum, cnt, mine, sp = 0u;
    for (;;) {
        sum = 0u; cnt = 0u; mine = 0u;
#pragma unroll
        for (unsigned j = 0; j < 16; ++j) { const unsigned c = xb_ld(&bar[XB_XCNT(j)]); sum += c; cnt += (c > 0u) ? 1u : 0u; mine = (j == x) ? c : mine; }
        if (sum == G) break;
        __builtin_amdgcn_s_sleep(1);
        if ((++sp & 255u) == 0u) { if (xb_ld(&bar[XB_TMO])) break; if (sp > XB_SPIN_CAP) { atomicAdd(&bar[XB_TMO], 1u); break; } }
    }
    nloc = mine > 0u ? mine : 1u; nx = cnt > 0u ? cnt : 1u;
}

__device__ __forceinline__ void xcd_barrier(const XcdBarrier& b) {
    asm volatile("s_waitcnt vmcnt(0)" ::: "memory");
    __syncthreads();
    if (threadIdx.x == 0) {
        unsigned* bar = b.bar; unsigned bx = b.x; asm volatile("" : "+s"(bar), "+s"(bx));
        __builtin_amdgcn_s_waitcnt(0);
        unsigned nloc = b.st[0], nx = b.st[1];
        if (nloc == 0u) { xcd_barrier_complete(bar, bx, nloc, nx); b.st[0] = nloc; b.st[1] = nx; }
        const unsigned old = xb_add(&bar[XB_XSUB(bx)], 1u);
        const unsigned gen = old / nloc;
        if (old + 1u == (gen + 1u) * nloc) {
            __builtin_amdgcn_fence(__ATOMIC_RELEASE, "agent");
            asm volatile("s_waitcnt vmcnt(0)" ::: "memory");
            const unsigned og = xb_add(&bar[XB_TOP], 1u);
            const unsigned tg = og / nx;
            if (og + 1u == (tg + 1u) * nx) xb_add(&bar[XB_TOPGEN], 1u);
            else XB_SPIN(xb_ld(&bar[XB_TOPGEN]) == tg, bar);
            __builtin_amdgcn_fence(__ATOMIC_ACQUIRE, "agent");
            xb_add(&bar[XB_XGEN(bx)], 1u);
            asm volatile("s_waitcnt vmcnt(0)" ::: "memory");
        } else {
            XB_SPIN(xb_ld(&bar[XB_XGEN(bx)]) == gen, bar);
            __builtin_amdgcn_fence(__ATOMIC_ACQUIRE, "agent");
            asm volatile("s_waitcnt vmcnt(0)" ::: "memory");
        }
    }
    __syncthreads();
}
struct TrArgs { const float* W; const float* gain; bf16* WT; int K, N, c0, nvalid, n0, k0; };
__device__ __forceinline__ void tr_load(const TrArgs& A, float (&v)[32], float (&g8)[8], int lane) {
    const int cc = lane & 31, c = lane & 7;
#pragma unroll
    for (int j = 0; j < 8; ++j) g8[j] = A.gain ? A.gain[A.k0 + 8 * c + j] : 1.f;
#pragma unroll
    for (int i = 0; i < 32; ++i) { const int kk = 2 * i + (lane >> 5); v[i] = (cc < A.nvalid) ? A.W[(size_t)(A.k0 + kk) * A.N + A.c0 + cc] : 0.f; }
}
__device__ __forceinline__ void tr_store(const TrArgs& A, const float (&v)[32], const float (&g8)[8], LAS float* scr, int lane) {
    const int cc = lane & 31, c = lane & 7;
#pragma unroll
    for (int i = 0; i < 32; ++i) scr[(2 * i + (lane >> 5)) * 33 + cc] = v[i];
    LDS_WAIT();
#pragma unroll
    for (int j = 0; j < 4; ++j) { const int n = (lane >> 3) + 8 * j; const LAS float* s = scr + (8 * c) * 33 + n;
        v4u o; o.x = pk2(s[0 * 33] * g8[0], s[1 * 33] * g8[1]); o.y = pk2(s[2 * 33] * g8[2], s[3 * 33] * g8[3]); o.z = pk2(s[4 * 33] * g8[4], s[5 * 33] * g8[5]); o.w = pk2(s[6 * 33] * g8[6], s[7 * 33] * g8[7]);
        *(GAS v4u*)(A.WT + (size_t)(A.n0 + n) * A.K + A.k0 + 8 * c) = o; }
    LDS_WAIT();
}
struct Ptrs {
    const float *x, *attn_norm, *w_in, *diff_lambda, *diff_subln, *w_out, *ffn_norm, *w_gate, *w_up, *w_down, *rel_bias, *final_norm; float* out;
    bf16 *WIN, *WOUT, *WGU, *WDN, *IK, *XB, *QO, *KK, *VT, *IQ, *ACT, *MIX; float *SS, *IW; unsigned* MASK;
};
__device__ __forceinline__ void prologue(const Ptrs& P, LAS unsigned char* lds, int gw, int NGW, int wave, int lane) {
    LAS float* scr = (LAS float*)(lds + RING_OFF + wave * 16384);
    constexpr int I_IN = (NIN / 32) * (DM / 64), I_OUT = (DM / 32) * (DM / 64), I_GU = (NGU / 32) * (DM / 64), I_DN = (DM / 32) * (DFF / 64), I_L = I_IN + I_OUT + I_GU + I_DN;
    auto decode = [&](int it) -> TrArgs {
        TrArgs A; const int l = it / I_L; int r = it % I_L;
        if (r < I_IN) { const int db = r / (DM / 64), kb = r % (DM / 64); int c0 = 0, nv = 32;
            if (db < 16) c0 = 32 * db; else if (db < 32) c0 = 2120 + 32 * (db - 16); else if (db < 48) c0 = 512 + 32 * (db - 32); else if (db < 64) c0 = 2632 + 32 * (db - 48);
            else if (db < 80) c0 = 1536 + 32 * (db - 64); else if (db < 82) c0 = 2048 + 32 * (db - 80); else if (db == 82) { c0 = 2112; nv = 8; } else if (db < 88) { c0 = 0; nv = 0; }
            else if (db < 104) c0 = 1024 + 32 * (db - 88); else c0 = 3144 + 32 * (db - 104);
            A.W = P.w_in + (size_t)l * DM * IN_COLS; A.K = DM; A.N = IN_COLS; A.c0 = c0; A.nvalid = nv; A.gain = P.attn_norm + l * DM; A.WT = P.WIN + (size_t)l * NIN * DM; A.n0 = 32 * db; A.k0 = 64 * kb; return A; }
        r -= I_IN;
        if (r < I_OUT) { const int db = r / (DM / 64), kb = r % (DM / 64);
            A.W = P.w_out + (size_t)l * DM * DM; A.K = DM; A.N = DM; A.c0 = 32 * db; A.nvalid = 32; A.gain = nullptr; A.WT = P.WOUT + (size_t)l * DM * DM; A.n0 = 32 * db; A.k0 = 64 * kb; return A; }
        r -= I_OUT;
        if (r < I_GU) { const int db = r / (DM / 64), kb = r % (DM / 64), pn = db >> 3, wb = db & 7;
            A.W = (wb < 4 ? P.w_gate : P.w_up) + (size_t)l * DM * DFF; A.K = DM; A.N = DFF; A.c0 = 128 * pn + 32 * (wb & 3); A.nvalid = 32; A.gain = P.ffn_norm + l * DM; A.WT = P.WGU + (size_t)l * NGU * DM; A.n0 = 32 * db; A.k0 = 64 * kb; return A; }
        r -= I_GU;
        { const int db = r / (DFF / 64), kb = r % (DFF / 64);
            A.W = P.w_down + (size_t)l * DFF * DM; A.K = DFF; A.N = DM; A.c0 = 32 * db; A.nvalid = 32; A.gain = nullptr; A.WT = P.WDN + (size_t)l * DM * DFF; A.n0 = 32 * db; A.k0 = 64 * kb; return A; }
    };
    {
        constexpr int TOTAL = DEPTH * I_L;
        int it = gw; TrArgs A = decode(it < TOTAL ? it : 0); float v[32], g8[8];
        if (it < TOTAL) tr_load(A, v, g8, lane);
        for (; it < TOTAL; it += NGW) {
            const int itn = it + NGW; const bool hn = itn < TOTAL; TrArgs B = decode(hn ? itn : 0); float vn[32], gn[8];
            if (hn) tr_load(B, vn, gn, lane);
            tr_store(A, v, g8, scr, lane);
            if (hn) { A = B;
#pragma unroll
                for (int i = 0; i < 32; ++i) v[i] = vn[i];
#pragma unroll
                for (int i = 0; i < 8; ++i) g8[i] = gn[i]; }
        }
    }
    for (int m0 = 4 * gw; m0 < M; m0 += 4 * NGW) {
        f32x4 xv[4][4];
#pragma unroll
        for (int rr = 0; rr < 4; ++rr) { const GAS f32x4* xr = (const GAS f32x4*)(P.x + (size_t)(m0 + rr) * DM) + lane;
#pragma unroll
            for (int j = 0; j < 4; ++j) xv[rr][j] = xr[64 * j]; }
#pragma unroll
        for (int rr = 0; rr < 4; ++rr) { GAS unsigned long long* o8 = (GAS unsigned long long*)(P.XB + (size_t)(m0 + rr) * DM) + lane; float s = 0.f;
#pragma unroll
            for (int j = 0; j < 4; ++j) { const f32x4 v = xv[rr][j]; s += (v.x * v.x + v.y * v.y) + (v.z * v.z + v.w * v.w);
                o8[64 * j] = (unsigned long long)pk2(v.x, v.y) | ((unsigned long long)pk2(v.z, v.w) << 32); }
            s = wave_sum(s);
            if (lane < 16) P.SS[(size_t)(m0 + rr) * 16 + lane] = lane == 0 ? s : 0.f; }
    }
}
__device__ __forceinline__ void final_norm_phase(const Ptrs& P, int gw, int NGW, int lane) {
    f32x4 gg[4];
#pragma unroll
    for (int j = 0; j < 4; ++j) gg[j] = ((const GAS f32x4*)P.final_norm + lane)[64 * j];
    for (int m0 = 4 * gw; m0 < M; m0 += 4 * NGW) {
        unsigned long long xv[4][4]; float r[4];
#pragma unroll
        for (int rr = 0; rr < 4; ++rr) { const GAS unsigned long long* xr = (const GAS unsigned long long*)(P.XB + (size_t)(m0 + rr) * DM) + lane;
#pragma unroll
            for (int j = 0; j < 4; ++j) xv[rr][j] = xr[64 * j]; }
#pragma unroll
        for (int rr = 0; rr < 4; ++rr) r[rr] = pg8::row_rs(P.SS, m0 + rr);
#pragma unroll
        for (int rr = 0; rr < 4; ++rr) { GAS f32x4* o = (GAS f32x4*)(P.out + (size_t)(m0 + rr) * DM) + lane;
#pragma unroll
            for (int j = 0; j < 4; ++j) { const unsigned lo = (unsigned)xv[rr][j], hi = (unsigned)(xv[rr][j] >> 32);
                o[64 * j] = (f32x4){bflo(lo) * r[rr] * gg[j].x, bfhi(lo) * r[rr] * gg[j].y, bflo(hi) * r[rr] * gg[j].z, bfhi(hi) * r[rr] * gg[j].w}; } }
    }
}
namespace idx {
typedef short bf16x8 __attribute__((ext_vector_type(8)));
typedef float f32x4v __attribute__((ext_vector_type(4)));
typedef float f32x32 __attribute__((ext_vector_type(32)));
constexpr int KSTR = 128, CHUNK = 128, CBUF = CHUNK * KSTR, K_OFF = 0, NSL = 4, CAND_OFF = NSL * CBUF  , IDX_LDS = CAND_OFF + 8 * 8192;
#define IDX_BAR() asm volatile("s_waitcnt lgkmcnt(0)\n\ts_barrier" ::: "memory")
__device__ __forceinline__ float relu(float x) { float r; asm("v_max_f32_e32 %0, 0, %1" : "=v"(r) : "v"(x)); return r; }
__device__ __forceinline__ float min3f(float a, float b, float c) { float r; asm("v_min3_f32 %0, %1, %2, %3" : "=v"(r) : "v"(a), "v"(b), "v"(c)); return r; }
__device__ __forceinline__ float max3g(float a, float b, float c) { float r; asm("v_max3_f32 %0, %1, %2, %3" : "=v"(r) : "v"(a), "v"(b), "v"(c)); return r; }
__device__ __forceinline__ float minf_s(float a, float b) { float r; asm("v_min_f32_e32 %0, %1, %2" : "=v"(r) : "v"(a), "v"(b)); return r; }
__device__ __forceinline__ float maxf_s(float a, float b) { float r; asm("v_max_f32_e32 %0, %1, %2" : "=v"(r) : "v"(a), "v"(b)); return r; }
__device__ __forceinline__ float rfl(float x) { return __builtin_bit_cast(float, __builtin_amdgcn_readfirstlane(__builtin_bit_cast(int, x))); }
#define WRL(m, val, ln) asm("v_writelane_b32 %0, %1, %2" : "+v"(m) : "s"(val), "n"(ln))
__device__ __forceinline__ int cnt8(float s0, float s1, float s2, float s3, float s4, float s5, float s6, float s7, float thr) {
    unsigned long long m0, m1, m2, m3, m4, m5, m6, m7;
    asm("v_cmp_ge_f32_e64 %0, %8, %16\n\tv_cmp_ge_f32_e64 %1, %9, %16\n\tv_cmp_ge_f32_e64 %2, %10, %16\n\tv_cmp_ge_f32_e64 %3, %11, %16\n\t"
        "v_cmp_ge_f32_e64 %4, %12, %16\n\tv_cmp_ge_f32_e64 %5, %13, %16\n\tv_cmp_ge_f32_e64 %6, %14, %16\n\tv_cmp_ge_f32_e64 %7, %15, %16"
        : "=&s"(m0), "=&s"(m1), "=&s"(m2), "=&s"(m3), "=&s"(m4), "=&s"(m5), "=&s"(m6), "=&s"(m7)
        : "v"(s0), "v"(s1), "v"(s2), "v"(s3), "v"(s4), "v"(s5), "v"(s6), "v"(s7), "v"(thr));
    return (__builtin_popcountll(m0) + __builtin_popcountll(m1)) + (__builtin_popcountll(m2) + __builtin_popcountll(m3)) + (__builtin_popcountll(m4) + __builtin_popcountll(m5)) + (__builtin_popcountll(m6) + __builtin_popcountll(m7));
}
#define CNT8(v, g, thr) cnt8(v[8 * (g)], v[8 * (g) + 1], v[8 * (g) + 2], v[8 * (g) + 3], v[8 * (g) + 4], v[8 * (g) + 5], v[8 * (g) + 6], v[8 * (g) + 7], thr)
template <int MODE> __device__ __forceinline__ void idx_unit(const Ptrs& P, int b, int grp, bool pf, int nb, int ngrp, bool& have, bf16x8& qa0, bf16x8& qa1, f32x4v& w4, LAS unsigned char* lds, int tid, int wave, int lane) {
    asm volatile("" : "+v"(tid), "+v"(lane));
    const int t0 = 16 * grp, nkeys = t0 + 16;
    if (nkeys <= 256) {
        const int tq = t0 + 2 * wave + (lane >> 5), l32 = lane & 31;
        GAS unsigned* mrow = (GAS unsigned*)(P.MASK + (size_t)(b * SEQ + tq) * 128);
#pragma unroll
        for (int i = 0; i < 4; ++i) { const int j = l32 + 32 * i, k0 = 32 * j; mrow[j] = (k0 + 31 <= tq) ? 0xFFFFFFFFu : (k0 > tq ? 0u : ((1u << (tq - k0 + 1)) - 1u)); }
        return;
    }
    const int nch = (nkeys + CHUNK - 1) / CHUNK, tq0 = t0 + 2 * wave, tq1 = tq0 + 1;
    const int srow = 16 * wave + (lane >> 3);
    const int kcol = ((lane & 7) ^ ((srow >> 1) & 7)) * 8, kcol2 = ((lane & 7) ^ (((srow + 8) >> 1) & 7)) * 8;
    unsigned ko1 = (unsigned)(srow * 64 + kcol) * 2u, ko2 = (unsigned)((srow + 8) * 64 + kcol2) * 2u;
    const char* kg = uni_ptr((const char*)(P.IK + (size_t)b * SEQ * 64));
#define IDX_DMA2(kga, c) do { const int sl_ = (c) & (NSL - 1); const char* cb_ = (kga) + (size_t)(c) * (CHUNK * 128); asm volatile("" : "+s"(cb_)); asm volatile("" : "+v"(ko1)); asm volatile("" : "+v"(ko2)); \
        __builtin_amdgcn_global_load_lds((const unsigned*)(cb_ + ko1), (LAS unsigned*)(lds + K_OFF + sl_ * CBUF + wave * 2048), 16, 0, 0); \
        __builtin_amdgcn_global_load_lds((const unsigned*)(cb_ + ko2), (LAS unsigned*)(lds + K_OFF + sl_ * CBUF + wave * 2048 + 1024), 16, 0, 0); } while (0)
#define IDX_DMA(c) IDX_DMA2(kg, c)
#define IDX_OPERANDS(bb, tq) do { const int m_ = lane & 15, kq_ = lane >> 4, g_ = lane >> 4; const bf16* qp_ = P.IQ + (size_t)((bb) * SEQ + (tq) + (m_ >> 3)) * 512 + (m_ & 7) * 64 + 8 * kq_; \
        qa0 = *(const bf16x8*)qp_; qa1 = *(const bf16x8*)(qp_ + 32); w4 = *(const f32x4v*)(P.IW + (size_t)((bb) * SEQ + (tq) + (g_ >> 1)) * 8 + 4 * (g_ & 1)); } while (0)
    if (!have) { IDX_OPERANDS(b, tq0); IDX_DMA(0); IDX_DMA(1); IDX_DMA(2); asm volatile("" : "+v"(qa0), "+v"(qa1), "+v"(w4)); }
    asm volatile("s_waitcnt vmcnt(4)" ::: "memory");
    __builtin_amdgcn_s_barrier();
    bf16x8 qa[2] = {qa0, qa1}; float wv[4] = {w4[0], w4[1], w4[2], w4[3]};
    f32x32 a0, a1, b0, b1;
#pragma unroll
    for (int i = 0; i < 32; ++i) { a0[i] = -INFINITY; a1[i] = -INFINITY; b0[i] = -INFINITY; b1[i] = -INFINITY; }
    float mn0 = INFINITY, mn1 = INFINITY, mx0 = -INFINITY, mx1 = -INFINITY;
    const LAS unsigned char* kb = lds + K_OFF + (lane & 15) * KSTR + (((lane >> 4) ^ ((lane >> 1) & 7)) * 16);
    const int kx = (int)(((unsigned)(size_t)kb ^ 64u) - (unsigned)(size_t)kb);
#define IDX_SB() __builtin_amdgcn_sched_barrier(0)
#define IDX_MF(a, b, c) __builtin_amdgcn_mfma_f32_16x16x32_bf16(a, b, c, 0, 0, 0)
#define IDX_RL(x) x = __int_as_float(max(__float_as_int(x), 0))
#define IDX_LOADF(f0, f1, f2, f3, p) do { const LAS unsigned char* p_ = (p); f0 = *(const LAS bf16x8*)p_; f1 = *(const LAS bf16x8*)(p_ + kx); f2 = *(const LAS bf16x8*)(p_ + 16 * KSTR); f3 = *(const LAS bf16x8*)(p_ + 16 * KSTR + kx); } while (0)
#define IDX_KEEP(f0, f1, f2, f3) asm volatile("" :: "v"(f0), "v"(f1), "v"(f2), "v"(f3), "v"(ta0), "v"(ta1))
#define IDX_STEP(dn0, dn1, f0, f1, f2, f3, do0, do1) do { const f32x4v z_ = {0.f, 0.f, 0.f, 0.f}; \
        ta0 = IDX_MF(qa[0], f0, z_); IDX_SB(); IDX_RL(do0[0]); IDX_RL(do0[1]); IDX_SB(); \
        ta1 = IDX_MF(qa[0], f2, z_); IDX_SB(); IDX_RL(do0[2]); IDX_RL(do0[3]); IDX_SB(); \
        dn0 = IDX_MF(qa[1], f1, ta0); IDX_SB(); IDX_RL(do1[0]); IDX_RL(do1[1]); IDX_SB(); \
        dn1 = IDX_MF(qa[1], f3, ta1); IDX_SB(); IDX_RL(do1[2]); IDX_RL(do1[3]); IDX_SB(); } while (0)
#define IDX_SUM(r, d0, d1) do { float p0_ = wv[0] * d0[0]; p0_ = __builtin_fmaf(wv[1], d0[1], p0_); p0_ = __builtin_fmaf(wv[2], d0[2], p0_); p0_ = __builtin_fmaf(wv[3], d0[3], p0_); \
        float p1_ = wv[0] * d1[0]; p1_ = __builtin_fmaf(wv[1], d1[1], p1_); p1_ = __builtin_fmaf(wv[2], d1[2], p1_); p1_ = __builtin_fmaf(wv[3], d1[3], p1_); \
        auto rr_ = __builtin_amdgcn_permlane16_swap(__float_as_uint(p0_), __float_as_uint(p1_), false, false); r = __uint_as_float(rr_[0]) + __uint_as_float(rr_[1]); } while (0)
#define IDX_FIN(re, ro, va, vb, koff) do { auto ss_ = __builtin_amdgcn_permlane32_swap(__float_as_uint(re), __float_as_uint(ro), false, false); float A_ = __uint_as_float(ss_[0]), B_ = __uint_as_float(ss_[1]); \
        mn0 = minf_s(mn0, A_); mn1 = minf_s(mn1, B_); \
        if (CHUNK * c + CHUNK - 1 > t0) { const int k_ = CHUNK * c + (koff) + lane; A_ = k_ > tq0 ? -INFINITY : A_; B_ = k_ > tq1 ? -INFINITY : B_; } \
        mx0 = maxf_s(mx0, A_); mx1 = maxf_s(mx1, B_); va[c] = A_; vb[c] = B_; } while (0)
    bf16x8 fa0, fa1, fa2, fa3, fb0, fb1, fb2, fb3; f32x4v da0, da1, db0, db1, ta0, ta1; float re, ro;
    IDX_LOADF(fa0, fa1, fa2, fa3, kb);
    for (int c = 0; c < nch; ++c) {
        const LAS unsigned char* kc = kb + (c & (NSL - 1)) * CBUF;
        IDX_LOADF(fb0, fb1, fb2, fb3, kc + 32 * KSTR);
        IDX_SB();
        { const f32x4v z_ = {0.f, 0.f, 0.f, 0.f}; da0 = IDX_MF(qa[0], fa0, z_); da1 = IDX_MF(qa[0], fa2, z_); da0 = IDX_MF(qa[1], fa1, da0); da1 = IDX_MF(qa[1], fa3, da1); }
        IDX_SB();
        if (c + 3 < nch) IDX_DMA(c + 3);
        IDX_SB();
        IDX_STEP(db0, db1, fb0, fb1, fb2, fb3, da0, da1);
        IDX_LOADF(fa0, fa1, fa2, fa3, kc + 64 * KSTR); IDX_KEEP(fb0, fb1, fb2, fb3);
        IDX_SUM(re, da0, da1);
        IDX_SB();
        IDX_STEP(da0, da1, fa0, fa1, fa2, fa3, db0, db1);
        IDX_LOADF(fb0, fb1, fb2, fb3, kc + 96 * KSTR); IDX_KEEP(fa0, fa1, fa2, fa3);
        IDX_SUM(ro, db0, db1);
        IDX_FIN(re, ro, a0, b0, 0);
        IDX_SB();
        IDX_STEP(db0, db1, fb0, fb1, fb2, fb3, da0, da1);
        IDX_SUM(re, da0, da1);
        if (c + 3 < nch) asm volatile("s_waitcnt vmcnt(4) lgkmcnt(0)" ::: "memory"); else asm volatile("s_waitcnt vmcnt(0) lgkmcnt(0)" ::: "memory");
        __builtin_amdgcn_s_barrier();
        IDX_LOADF(fa0, fa1, fa2, fa3, kb + ((c + 1) & (NSL - 1)) * CBUF); IDX_KEEP(fb0, fb1, fb2, fb3);
        IDX_SB();
        IDX_RL(db0[0]); IDX_RL(db0[1]); IDX_RL(db0[2]); IDX_RL(db0[3]); IDX_RL(db1[0]); IDX_RL(db1[1]); IDX_RL(db1[2]); IDX_RL(db1[3]);
        IDX_SUM(ro, db0, db1);
        IDX_FIN(re, ro, a1, b1, 64);
    }
    asm volatile("s_waitcnt lgkmcnt(0)" :: "v"(fa0), "v"(fa1), "v"(fa2), "v"(fa3) : "memory");
#undef IDX_SB
#undef IDX_MF
#undef IDX_RL
#undef IDX_LOADF
#undef IDX_KEEP
#undef IDX_STEP
#undef IDX_SUM
#undef IDX_FIN
    have = false;
    if (pf) { const char* kgn = uni_ptr((const char*)(P.IK + (size_t)nb * SEQ * 64));
        IDX_OPERANDS(nb, 16 * ngrp + 2 * wave); IDX_DMA2(kgn, 0); IDX_DMA2(kgn, 1); IDX_DMA2(kgn, 2); have = true; }
#undef IDX_DMA
#undef IDX_DMA2
#undef IDX_OPERANDS
    if (MODE == 1) { float* dump = (float*)(P.MIX) + (size_t)M * 512 + ((size_t)(b * 256 + grp) * 512 + tid) * 4;
        float sa = 0.f, sb = 0.f;
#pragma unroll
        for (int i = 0; i < 32; ++i) { sa += a0[i] + a1[i]; sb += b0[i] + b1[i]; }
        dump[0] = sa; dump[1] = sb; dump[2] = mn0 + mx0; dump[3] = mn1 + mx1; return; }
#pragma unroll
    for (int m = 1; m < 64; m <<= 1) { mn0 = fminf(mn0, __shfl_xor(mn0, m)); mn1 = fminf(mn1, __shfl_xor(mn1, m)); mx0 = fmaxf(mx0, __shfl_xor(mx0, m)); mx1 = fmaxf(mx1, __shfl_xor(mx1, m)); }
    float lo0 = rfl(mn0), lo1 = rfl(mn1), hi0 = rfl(mx0), hi1 = rfl(mx1), thr0 = lo0, thr1 = lo1;
    hi0 += fmaxf(fabsf(hi0) * 1e-6f, 1e-30f); hi1 += fmaxf(fabsf(hi1) * 1e-6f, 1e-30f);
    constexpr int CAND = 512;
    bool done0 = false, done1 = false; int clo0 = tq0 + 1, clo1 = tq1 + 1, chi0 = 0, chi1 = 0;
    for (int it = 0; it < 64; ++it) {
        if ((done0 || clo0 - chi0 <= CAND) && (done1 || clo1 - chi1 <= CAND)) break;
        const float mid0 = 0.5f * lo0 + 0.5f * hi0, mid1 = 0.5f * lo1 + 0.5f * hi1;
        if (!done0 && (mid0 <= lo0 || mid0 >= hi0)) { thr0 = lo0; done0 = true; }
        if (!done1 && (mid1 <= lo1 || mid1 >= hi1)) { thr1 = lo1; done1 = true; }
        if (done0 && done1) break;
        int c0 = 0, c1 = 0;
#pragma unroll
        for (int g = 0; g < 4; ++g) if (nch > 8 * g) {
            c0 += CNT8(a0, g, mid0) + CNT8(a1, g, mid0); c1 += CNT8(b0, g, mid1) + CNT8(b1, g, mid1); }
        if (!done0) { if (c0 == 256) { thr0 = mid0; done0 = true; } else if (c0 > 256) { lo0 = mid0; clo0 = c0; } else { hi0 = mid0; chi0 = c0; } }
        if (!done1) { if (c1 == 256) { thr1 = mid1; done1 = true; } else if (c1 > 256) { lo1 = mid1; clo1 = c1; } else { hi1 = mid1; chi1 = c1; } }
    }
    LAS float* cl0 = (LAS float*)(lds + CAND_OFF + wave * 8192); LAS float* cl1 = cl0 + 1024;
    int m0 = 0, m1 = 0;
#define IDX_COMPACT(v, lo, hi, list, m) do { const float v_ = (v); const bool in_ = (v_ >= (lo)) && (v_ < (hi)); const unsigned long long bm_ = __ballot(in_); \
        if (bm_) { const int pre_ = __builtin_amdgcn_mbcnt_hi((unsigned)(bm_ >> 32), __builtin_amdgcn_mbcnt_lo((unsigned)bm_, 0u)); if (in_) (list)[(m) + pre_] = v_; (m) += __builtin_popcountll(bm_); } } while (0)
    if (!done0) {
#pragma unroll
        for (int c = 0; c < 32; ++c) if (c < nch) { IDX_COMPACT(a0[c], lo0, hi0, cl0, m0); IDX_COMPACT(a1[c], lo0, hi0, cl0, m0); } }
    if (!done1) {
#pragma unroll
        for (int c = 0; c < 32; ++c) if (c < nch) { IDX_COMPACT(b0[c], lo1, hi1, cl1, m1); IDX_COMPACT(b1[c], lo1, hi1, cl1, m1); } }
#undef IDX_COMPACT
    LDS_WAIT();
    float cr0[8], cr1[8];
#pragma unroll
    for (int k = 0; k < 8; ++k) { const int i = 64 * k + lane; cr0[k] = (i < m0) ? cl0[i] : -INFINITY; cr1[k] = (i < m1) ? cl1[i] : -INFINITY; }
    LDS_WAIT();
    const int k0 = 256 - chi0, k1 = 256 - chi1;
    for (int it = 0; it < 64; ++it) {
        const float mid0 = 0.5f * lo0 + 0.5f * hi0, mid1 = 0.5f * lo1 + 0.5f * hi1;
        if (!done0 && (mid0 <= lo0 || mid0 >= hi0)) { thr0 = lo0; done0 = true; }
        if (!done1 && (mid1 <= lo1 || mid1 >= hi1)) { thr1 = lo1; done1 = true; }
        if (done0 && done1) break;
        const int c0 = cnt8(cr0[0], cr0[1], cr0[2], cr0[3], cr0[4], cr0[5], cr0[6], cr0[7], mid0);
        const int c1 = cnt8(cr1[0], cr1[1], cr1[2], cr1[3], cr1[4], cr1[5], cr1[6], cr1[7], mid1);
        if (!done0) { if (c0 == k0) { thr0 = mid0; done0 = true; } else if (c0 > k0) lo0 = mid0; else hi0 = mid0; }
        if (!done1) { if (c1 == k1) { thr1 = mid1; done1 = true; } else if (c1 > k1) lo1 = mid1; else hi1 = mid1; }
    }
    if (!done0) thr0 = lo0;
    if (!done1) thr1 = lo1;
    if (MODE == 2) { float* dump = (float*)(P.MIX) + (size_t)M * 512 + ((size_t)(b * 256 + grp) * 512 + tid) * 4; dump[0] = thr0; dump[1] = thr1; return; }
    if (have) asm volatile("" : "+v"(qa0), "+v"(qa1), "+v"(w4));
    unsigned m0a = 0u, m0b = 0u, m1a = 0u, m1b = 0u;
#pragma unroll
    for (int c = 0; c < 32; ++c) if (c < nch) {
        const unsigned long long e0 = __ballot(a0[c] >= thr0), e1 = __ballot(a1[c] >= thr0), f0 = __ballot(b0[c] >= thr1), f1 = __ballot(b1[c] >= thr1);
        if (c < 16) { WRL(m0a, (unsigned)e0, 4 * c); WRL(m0a, (unsigned)(e0 >> 32), 4 * c + 1); WRL(m0a, (unsigned)e1, 4 * c + 2); WRL(m0a, (unsigned)(e1 >> 32), 4 * c + 3);
                      WRL(m1a, (unsigned)f0, 4 * c); WRL(m1a, (unsigned)(f0 >> 32), 4 * c + 1); WRL(m1a, (unsigned)f1, 4 * c + 2); WRL(m1a, (unsigned)(f1 >> 32), 4 * c + 3); }
        else { const int cc = c - 16;
               WRL(m0b, (unsigned)e0, 4 * cc); WRL(m0b, (unsigned)(e0 >> 32), 4 * cc + 1); WRL(m0b, (unsigned)e1, 4 * cc + 2); WRL(m0b, (unsigned)(e1 >> 32), 4 * cc + 3);
               WRL(m1b, (unsigned)f0, 4 * cc); WRL(m1b, (unsigned)(f0 >> 32), 4 * cc + 1); WRL(m1b, (unsigned)f1, 4 * cc + 2); WRL(m1b, (unsigned)(f1 >> 32), 4 * cc + 3); }
    }
    { GAS unsigned* r0 = (GAS unsigned*)(P.MASK + (size_t)(b * SEQ + tq0) * 128); GAS unsigned* r1 = (GAS unsigned*)(P.MASK + (size_t)(b * SEQ + tq1) * 128);
      r0[lane] = m0a; r0[64 + lane] = m0b; r1[lane] = m1a; r1[64 + lane] = m1b; }
}
template <int MODE> __device__ __forceinline__ void idx_phase(const Ptrs& P, LAS unsigned char* lds, int bid, int G, int tid, int wave, int lane) {
    for (int vb = bid; vb < 256; vb += G) {
        const int vcu = (vb & 7) * 32 + (vb >> 3);
        bf16x8 qa0, qa1; f32x4v w4; bool have = false;
        for (int b = 0; b < BATCH; ++b) { const int grp = (b & 1) ? 255 - vcu : vcu, nb = b + 1, ngrp = (nb & 1) ? 255 - vcu : vcu;
            idx_unit<MODE>(P, b, grp, nb < BATCH && 16 * ngrp + 16 > 256, nb, ngrp, have, qa0, qa1, w4, lds, tid, wave, lane); }
    }
}
#undef IDX_BAR
}

namespace att {
typedef short bf16x8 __attribute__((ext_vector_type(8)));
typedef float f32x16 __attribute__((ext_vector_type(16)));
typedef unsigned u32x2 __attribute__((ext_vector_type(2)));
typedef float f32x2v __attribute__((ext_vector_type(2)));
constexpr int NSLOT = 4, KSLOT = 8192, VSLOT = 16384;
constexpr int K_OFF = 0, V_OFF = NSLOT * KSLOT, WSF_OFF = V_OFF + NSLOT * VSLOT, OST_OFF = V_OFF  , MSK_OFF = WSF_OFF + 8 * 256  , ATT_LDS = MSK_OFF + 8 * 4096;
__device__ __forceinline__ int crow(int r, int hi) { return (r & 3) + 8 * (r >> 2) + 4 * hi; }
#define ATT_BAR() asm volatile("s_waitcnt lgkmcnt(0)\n\ts_barrier" ::: "memory")
__device__ __forceinline__ float swap_max(float m) { auto rr = __builtin_amdgcn_permlane32_swap(__float_as_uint(m), __float_as_uint(m), false, false); return fmaxf(__uint_as_float(rr[0]), __uint_as_float(rr[1])); }
__device__ __forceinline__ float swap_sum(float m) { auto rr = __builtin_amdgcn_permlane32_swap(__float_as_uint(m), __float_as_uint(m), false, false); return __uint_as_float(rr[0]) + __uint_as_float(rr[1]); }
__device__ __forceinline__ unsigned cvtpk(float lo, float hi) { unsigned r; asm("v_cvt_pk_bf16_f32 %0, %1, %2" : "=v"(r) : "v"(lo), "v"(hi)); return r; }
__device__ __forceinline__ float fadd_s(float a, float b) { float r; asm("v_add_f32_e32 %0, %1, %2" : "=v"(r) : "v"(a), "v"(b)); return r; }
__device__ __forceinline__ float fsub_s(float a, float b) { float r; asm("v_sub_f32_e32 %0, %1, %2" : "=v"(r) : "v"(a), "v"(b)); return r; }
__device__ __forceinline__ float max3f(float a, float b, float c) { float r; asm("v_max3_f32 %0, %1, %2, %3" : "=v"(r) : "v"(a), "v"(b), "v"(c)); return r; }
__device__ __forceinline__ int med3i(int a, int b, int c) { int r; asm("v_med3_i32 %0, %1, %2, %3" : "=v"(r) : "v"(a), "v"(b), "v"(c)); return r; }
__device__ __forceinline__ unsigned bfe1(unsigned w, int c) { unsigned r; asm("v_bfe_i32 %0, %1, %2, 1" : "=v"(r) : "v"(w), "n"(c)); return r; }
typedef float f32x2m __attribute__((ext_vector_type(2)));
typedef __bf16 bf16x2m __attribute__((ext_vector_type(2)));
__device__ __forceinline__ unsigned cvtpk_m(float lo, float hi) { const f32x2m v = {lo, hi}; const bf16x2m b = __builtin_convertvector(v, bf16x2m); return __builtin_bit_cast(unsigned, b); }
__device__ __forceinline__ bf16x8 pack8m(const f32x16& p, int b) { v4u w; w.x = cvtpk_m(p[b], p[b + 1]); w.y = cvtpk_m(p[b + 2], p[b + 3]); w.z = cvtpk_m(p[b + 4], p[b + 5]); w.w = cvtpk_m(p[b + 6], p[b + 7]); return __builtin_bit_cast(bf16x8, w); }
__device__ __forceinline__ bf16x8 pack8(const f32x16& p, int b) { v4u w; w.x = cvtpk(p[b], p[b + 1]); w.y = cvtpk(p[b + 2], p[b + 3]); w.z = cvtpk(p[b + 4], p[b + 5]); w.w = cvtpk(p[b + 6], p[b + 7]); return __builtin_bit_cast(bf16x8, w); }

template <int DV, bool MASKED>
__device__ __forceinline__ void attn_pass(f32x16 (&o)[DV / 32], const bf16* Q, const bf16* K, const bf16* VT, const unsigned* MASKb, const LAS float* bias,
                                          int q0, int nt, LAS unsigned char* lds, int tid, int wave, int lane) {
    asm volatile("" : "+v"(tid), "+v"(lane));
    const int r32 = lane & 31, hi = lane >> 5, qw0 = q0 + 32 * wave, qpos = qw0 + r32, tmax = (qw0 + 31) >> 6;
    bf16x8 qf[4];
#pragma unroll
    for (int s = 0; s < 4; ++s) qf[s] = *(const bf16x8*)(Q + (size_t)qpos * 1024 + 16 * s + 8 * hi);
    const int srow = 8 * wave + (lane >> 3), spc = ((lane & 7) ^ ((srow >> 1) & 7)) * 8;
    unsigned koff = (unsigned)(srow * 1024 + spc) * 2u, voff = (unsigned)(srow * M + spc) * 2u, moff = (unsigned)qpos * 512u;
    const char* Ku = uni_ptr((const char*)K); const char* Vu = uni_ptr((const char*)VT); const char* Mu = MASKED ? uni_ptr((const char*)MASKb) : nullptr;
    LAS float* wsf = (LAS float*)(lds + WSF_OFF + wave * 256);
    constexpr bool SPLIT = !MASKED && DV == 128;
    constexpr int KV_OPS = 1 + DV / 64 + (MASKED ? 1 : 0);
    static_assert(KV_OPS == 3, "the counted waits assume three LDS-DMA operations per tile per wave");
#define ATT_VB(v) asm volatile("" : "+v"(v))
#define ATT_SB(p) asm volatile("" : "+s"(p))
#define ATT_DMA(t) do { const int sl_ = (t) & (NSLOT - 1); \
        if (MASKED) { const char* mb_ = Mu + (size_t)(16 * ((t) >> 1)); ATT_SB(mb_); ATT_VB(moff); __builtin_amdgcn_global_load_lds((const unsigned*)(mb_ + moff), (LAS unsigned*)(lds + MSK_OFF + wave * 4096 + sl_ * 1024), 16, 0, 0); } \
        { const char* kb_ = Ku + (size_t)(t) * 131072; ATT_SB(kb_); ATT_VB(koff); __builtin_amdgcn_global_load_lds((const unsigned*)(kb_ + koff), (LAS unsigned*)(lds + K_OFF + sl_ * KSLOT + wave * 1024), 16, 0, 0); } \
        _Pragma("unroll") for (int i_ = 0; i_ < DV / 64; ++i_) { const char* vb_ = Vu + ((size_t)i_ * 128 * M + (size_t)(t) * 128); ATT_SB(vb_); ATT_VB(voff); \
            __builtin_amdgcn_global_load_lds((const unsigned*)(vb_ + voff), (LAS unsigned*)(lds + V_OFF + sl_ * VSLOT + i_ * 8192 + wave * 1024), 16, 0, 0); } } while (0)
    asm volatile("s_waitcnt lgkmcnt(0)\n\ts_barrier" ::: "memory");
    ATT_DMA(0);
    if (nt > 1) ATT_DMA(1);
    if (nt > 2) ATT_DMA(2);
    int xo[4];
#pragma unroll
    for (int s = 0; s < 4; ++s) xo[s] = r32 * 128 + (((2 * s + hi) ^ ((r32 >> 1) & 7)) * 16);
    if (nt > 2) asm volatile("s_waitcnt vmcnt(3)" ::: "memory");
    else asm volatile("s_waitcnt vmcnt(0)" ::: "memory");
    __builtin_amdgcn_s_barrier();
    bf16x8 kf[8];
#pragma unroll
    for (int s = 0; s < 4; ++s) { kf[2 * s] = *(const LAS bf16x8*)(lds + K_OFF + xo[s]); kf[2 * s + 1] = *(const LAS bf16x8*)(lds + K_OFF + xo[s] + 4096); }
    float lsum = 0.f, one = 1.f; asm volatile("" : "+v"(one));
    f32x16 negm;
#pragma unroll
    for (int r = 0; r < 16; ++r) negm[r] = 0.f;
#pragma unroll
    for (int d0 = 0; d0 < DV / 32; ++d0)
#pragma unroll
        for (int r = 0; r < 16; ++r) o[d0][r] = 0.f;
    for (int t = 0; t < nt; ++t) {
        const int slot = t & (NSLOT - 1);
        if (t <= tmax) {
            f32x16 p0, p1;
            const LAS unsigned char* vb = lds + V_OFF + slot * VSLOT;
            bf16x8 vf[8], vg2[DV == 128 ? 8 : 1]; u32x2 mw = {0u, 0u};
            __builtin_amdgcn_sched_barrier(0);
#pragma unroll
            for (int s = 0; s < 4; ++s) { p0 = __builtin_amdgcn_mfma_f32_32x32x16_bf16(kf[2 * s], qf[s], s == 0 ? negm : p0, 0, 0, 0); p1 = __builtin_amdgcn_mfma_f32_32x32x16_bf16(kf[2 * s + 1], qf[s], s == 0 ? negm : p1, 0, 0, 0); }
            __builtin_amdgcn_sched_barrier(0);
            if (t + 3 < nt) ATT_DMA(t + 3);
            __builtin_amdgcn_sched_barrier(0);
            asm volatile("s_nop 15" : "+v"(p0), "+v"(p1));
            __builtin_amdgcn_sched_barrier(0);
            const int kv0 = 64 * t;
            if (kv0 + 63 + 113 > qw0) {
                const int dq = qpos - kv0 - 4 * hi + 1;
#pragma unroll
                for (int r = 0; r < 16; ++r) { const int d = dq - ((r & 3) + 8 * (r >> 2));
                    p0[r] += bias[med3i(d, 0, 128)]; p1[r] += bias[med3i(d - 32, 0, 128)]; }
            }
            float rm;
            { float a = max3f(p0[0], p0[1], p1[0]), b = max3f(p0[2], p0[3], p1[1]); a = max3f(a, p1[2], p1[3]);
#pragma unroll
              for (int r = 4; r < 16; r += 4) { a = max3f(a, p0[r], p0[r + 1]); b = max3f(b, p0[r + 2], p0[r + 3]); a = max3f(a, p1[r], p1[r + 1]); b = max3f(b, p1[r + 2], p1[r + 3]); }
              rm = swap_max(max3f(a, b, b)); }
            if (__any(rm > 8.f) || t == 0) {
                const float dl = (t == 0) ? (rm == -INFINITY ? 0.f : rm) : fmaxf(rm, 0.f), f = (t == 0) ? 1.f : __builtin_amdgcn_exp2f(-dl); lsum *= f;
#pragma unroll
                for (int r = 0; r < 16; ++r) negm[r] -= dl;
#pragma unroll
                for (int r = 0; r < 16; ++r) { p0[r] -= dl; p1[r] -= dl; }
                if (hi == 0) wsf[r32] = f;
                LDS_WAIT();
#pragma unroll
                for (int r = 0; r < 16; ++r) { const float fr = wsf[crow(r, hi)];
#pragma unroll
                    for (int d0 = 0; d0 < DV / 32; ++d0) o[d0][r] *= fr; }
                LDS_WAIT();
            }
            if (DV == 64) {
#pragma unroll
            for (int j = 0; j < 4; ++j) { vf[j] = *(const LAS bf16x8*)(vb + xo[j]); vf[4 + j] = *(const LAS bf16x8*)(vb + xo[j] + 4096); } }
            if (DV == 128) {
#pragma unroll
                for (int j = 0; j < 4; ++j) { vg2[DV == 128 ? j : 0] = *(const LAS bf16x8*)(vb + xo[j] + 8192); vg2[DV == 128 ? 4 + j : 0] = *(const LAS bf16x8*)(vb + xo[j] + 12288); } }
            if (SPLIT) {
#pragma unroll
            for (int j = 0; j < 4; ++j) { vf[j] = *(const LAS bf16x8*)(vb + xo[j]); vf[4 + j] = *(const LAS bf16x8*)(vb + xo[j] + 4096); } }
            if (DV == 128 && !SPLIT) {
            if (t + 1 < nt) { const LAS unsigned char* kn = lds + K_OFF + ((t + 1) & (NSLOT - 1)) * KSLOT;
#pragma unroll
                for (int s = 0; s < 4; ++s) { kf[2 * s] = *(const LAS bf16x8*)(kn + xo[s]); kf[2 * s + 1] = *(const LAS bf16x8*)(kn + xo[s] + 4096); } }
            }
            bf16x8 pa0, pa1, pa2, pa3;
            if (MASKED) {
#pragma unroll
            for (int r = 0; r < 16; ++r) { p0[r] = __builtin_amdgcn_exp2f(p0[r]); p1[r] = __builtin_amdgcn_exp2f(p1[r]); }
            } else {
            if (SPLIT) {
#pragma unroll
            for (int r = 0; r < 16; ++r) p0[r] = __builtin_amdgcn_exp2f(p0[r]);
            float sa = p0[0];
#pragma unroll
            for (int r = 1; r < 16; ++r) sa += p0[r];
            pa0 = pack8m(p0, 0); pa1 = pack8m(p0, 8);
            lsum += sa;
            } else {
#pragma unroll
            for (int r = 0; r < 16; ++r) { p0[r] = __builtin_amdgcn_exp2f(p0[r]); p1[r] = __builtin_amdgcn_exp2f(p1[r]); }
            float sa = p0[0], sb = p1[0];
#pragma unroll
            for (int r = 1; r < 16; ++r) { sa += p0[r]; sb = __builtin_fmaf(p1[r], one, sb); }
            pa0 = pack8m(p0, 0); pa1 = pack8m(p0, 8); pa2 = pack8m(p1, 0); pa3 = pack8m(p1, 8);
            lsum += sa + sb;
            }
            }
            if (MASKED) { mw = *(const LAS u32x2*)(lds + MSK_OFF + wave * 4096 + slot * 1024 + r32 * 16 + (t & 1) * 8); const unsigned w0 = mw.x >> (4 * hi), w1 = mw.y >> (4 * hi);
                p0[0] = __uint_as_float(__float_as_uint(p0[0]) & bfe1(w0, 0)); p1[0] = __uint_as_float(__float_as_uint(p1[0]) & bfe1(w1, 0));
                p0[1] = __uint_as_float(__float_as_uint(p0[1]) & bfe1(w0, 1)); p1[1] = __uint_as_float(__float_as_uint(p1[1]) & bfe1(w1, 1));
                p0[2] = __uint_as_float(__float_as_uint(p0[2]) & bfe1(w0, 2)); p1[2] = __uint_as_float(__float_as_uint(p1[2]) & bfe1(w1, 2));
                p0[3] = __uint_as_float(__float_as_uint(p0[3]) & bfe1(w0, 3)); p1[3] = __uint_as_float(__float_as_uint(p1[3]) & bfe1(w1, 3));
                p0[4] = __uint_as_float(__float_as_uint(p0[4]) & bfe1(w0, 8)); p1[4] = __uint_as_float(__float_as_uint(p1[4]) & bfe1(w1, 8));
                p0[5] = __uint_as_float(__float_as_uint(p0[5]) & bfe1(w0, 9)); p1[5] = __uint_as_float(__float_as_uint(p1[5]) & bfe1(w1, 9));
                p0[6] = __uint_as_float(__float_as_uint(p0[6]) & bfe1(w0, 10)); p1[6] = __uint_as_float(__float_as_uint(p1[6]) & bfe1(w1, 10));
                p0[7] = __uint_as_float(__float_as_uint(p0[7]) & bfe1(w0, 11)); p1[7] = __uint_as_float(__float_as_uint(p1[7]) & bfe1(w1, 11));
                p0[8] = __uint_as_float(__float_as_uint(p0[8]) & bfe1(w0, 16)); p1[8] = __uint_as_float(__float_as_uint(p1[8]) & bfe1(w1, 16));
                p0[9] = __uint_as_float(__float_as_uint(p0[9]) & bfe1(w0, 17)); p1[9] = __uint_as_float(__float_as_uint(p1[9]) & bfe1(w1, 17));
                p0[10] = __uint_as_float(__float_as_uint(p0[10]) & bfe1(w0, 18)); p1[10] = __uint_as_float(__float_as_uint(p1[10]) & bfe1(w1, 18));
                p0[11] = __uint_as_float(__float_as_uint(p0[11]) & bfe1(w0, 19)); p1[11] = __uint_as_float(__float_as_uint(p1[11]) & bfe1(w1, 19));
                p0[12] = __uint_as_float(__float_as_uint(p0[12]) & bfe1(w0, 24)); p1[12] = __uint_as_float(__float_as_uint(p1[12]) & bfe1(w1, 24));
                p0[13] = __uint_as_float(__float_as_uint(p0[13]) & bfe1(w0, 25)); p1[13] = __uint_as_float(__float_as_uint(p1[13]) & bfe1(w1, 25));
                p0[14] = __uint_as_float(__float_as_uint(p0[14]) & bfe1(w0, 26)); p1[14] = __uint_as_float(__float_as_uint(p1[14]) & bfe1(w1, 26));
                p0[15] = __uint_as_float(__float_as_uint(p0[15]) & bfe1(w0, 27)); p1[15] = __uint_as_float(__float_as_uint(p1[15]) & bfe1(w1, 27));
            }
            if (MASKED) { float sa = fadd_s(p0[0], p1[0]), sb = fadd_s(p0[1], p1[1]);
#pragma unroll
              for (int r = 2; r < 16; r += 2) { sa = fadd_s(sa, p0[r]); sb = fadd_s(sb, p0[r + 1]); sa = fadd_s(sa, p1[r]); sb = fadd_s(sb, p1[r + 1]); }
              lsum += sa + sb;
              pa0 = pack8(p0, 0); pa1 = pack8(p0, 8); pa2 = pack8(p1, 0); pa3 = pack8(p1, 8); }
            __builtin_amdgcn_sched_barrier(0);
            if (DV != 128) {
            if (t + 1 < nt) { const LAS unsigned char* kn = lds + K_OFF + ((t + 1) & (NSLOT - 1)) * KSLOT;
#pragma unroll
                for (int s = 0; s < 4; ++s) { kf[2 * s] = *(const LAS bf16x8*)(kn + xo[s]); kf[2 * s + 1] = *(const LAS bf16x8*)(kn + xo[s] + 4096); } }
            }
            if (DV == 128 && !SPLIT) {
#pragma unroll
            for (int j = 0; j < 4; ++j) { vf[j] = *(const LAS bf16x8*)(vb + xo[j]); vf[4 + j] = *(const LAS bf16x8*)(vb + xo[j] + 4096); } }
            __builtin_amdgcn_sched_barrier(0);
            if (SPLIT) {
                float sa = 0.f, f0 = 0.f, f1 = 0.f; unsigned w0 = 0u, w1 = 0u, w2 = 0u, w3 = 0u, w4 = 0u, w5 = 0u, w6 = 0u, w7 = 0u;
#define ATT_W(k, v) do { if ((k) == 0) w0 = (v); else if ((k) == 1) w1 = (v); else if ((k) == 2) w2 = (v); else if ((k) == 3) w3 = (v); else if ((k) == 4) w4 = (v); else if ((k) == 5) w5 = (v); else if ((k) == 6) w6 = (v); else w7 = (v); } while (0)
#pragma unroll
                for (int k = 0; k < 8; ++k) {
                    const int j = (k >> 1) & 1, d = (k < 4 ? 2 : 0) + (k & 1);
                    o[DV == 128 ? d : 0] = __builtin_amdgcn_mfma_f32_32x32x16_bf16(j == 0 ? pa0 : pa1, d < 2 ? vf[4 * (d & 1) + j] : vg2[DV == 128 ? 4 * (d & 1) + j : 0], o[DV == 128 ? d : 0], 0, 0, 0);
                    const float e0 = __builtin_amdgcn_exp2f(p1[2 * k]), e1 = __builtin_amdgcn_exp2f(p1[2 * k + 1]);
                    if (k > 0) { sa += f0; sa += f1; ATT_W(k - 1, cvtpk_m(f0, f1)); }
                    f0 = e0; f1 = e1;
                    __builtin_amdgcn_sched_barrier(0);
                }
                sa += f0; sa += f1; w7 = cvtpk_m(f0, f1);
                lsum += sa;
                { v4u q; q.x = w0; q.y = w1; q.z = w2; q.w = w3; pa2 = __builtin_bit_cast(bf16x8, q); q.x = w4; q.y = w5; q.z = w6; q.w = w7; pa3 = __builtin_bit_cast(bf16x8, q); }
#undef ATT_W
                __builtin_amdgcn_sched_barrier(0);
                const LAS unsigned char* kn = lds + K_OFF + ((t + 1) & (NSLOT - 1)) * KSLOT;
#pragma unroll
                for (int k = 0; k < 8; ++k) {
                    const int j = (k >> 1) & 1, d = (k < 4 ? 2 : 0) + (k & 1);
                    o[DV == 128 ? d : 0] = __builtin_amdgcn_mfma_f32_32x32x16_bf16(j == 0 ? pa2 : pa3, d < 2 ? vf[4 * (d & 1) + 2 + j] : vg2[DV == 128 ? 4 * (d & 1) + 2 + j : 0], o[DV == 128 ? d : 0], 0, 0, 0);
                    if (k < 4) { kf[2 * k] = *(const LAS bf16x8*)(kn + xo[k]); kf[2 * k + 1] = *(const LAS bf16x8*)(kn + xo[k] + 4096); __builtin_amdgcn_sched_barrier(0); }
                }
            } else {
            if (DV == 128) {
#pragma unroll
                for (int d0 = 0; d0 < 2; ++d0)
#pragma unroll
                    for (int j = 0; j < 4; ++j) o[DV == 128 ? 2 + d0 : d0] = __builtin_amdgcn_mfma_f32_32x32x16_bf16(j == 0 ? pa0 : j == 1 ? pa1 : j == 2 ? pa2 : pa3, vg2[DV == 128 ? 4 * d0 + j : 0], o[DV == 128 ? 2 + d0 : d0], 0, 0, 0);
            }
#pragma unroll
            for (int d0 = 0; d0 < 2; ++d0)
#pragma unroll
                for (int j = 0; j < 4; ++j) o[d0] = __builtin_amdgcn_mfma_f32_32x32x16_bf16(j == 0 ? pa0 : j == 1 ? pa1 : j == 2 ? pa2 : pa3, vf[4 * d0 + j], o[d0], 0, 0, 0);
            }
            __builtin_amdgcn_sched_barrier(0);
        }
        if (t + 3 < nt) asm volatile("s_waitcnt vmcnt(3) lgkmcnt(0)" ::: "memory");
        else asm volatile("s_waitcnt vmcnt(0) lgkmcnt(0)" ::: "memory");
        __builtin_amdgcn_s_barrier();
    }
#undef ATT_DMA
#undef ATT_SB
#undef ATT_VB
    { float gt;
      if (DV == 128) asm volatile("v_mov_b32 %0, %1\n\tv_mov_b32 %0, %2\n\tv_mov_b32 %0, %3\n\tv_mov_b32 %0, %4\n\ts_nop 1" : "=&v"(gt) : "v"(o[1][15]), "v"(o[0][15]), "v"(o[DV == 128 ? 3 : 1][15]), "v"(o[DV == 128 ? 2 : 0][15]));
      else asm volatile("v_mov_b32 %0, %1\n\tv_mov_b32 %0, %2\n\ts_nop 1" : "=&v"(gt) : "v"(o[1][15]), "v"(o[0][15]));
      asm volatile("" :: "v"(gt)); }
    lsum = swap_sum(lsum);
    if (hi == 0) wsf[r32] = __builtin_amdgcn_rcpf(lsum);
    LDS_WAIT();
#pragma unroll
    for (int r = 0; r < 16; ++r) { const float fr = wsf[crow(r, hi)];
#pragma unroll
        for (int d0 = 0; d0 < DV / 32; ++d0) o[d0][r] *= fr; }
    LDS_WAIT();
}
#define PA_SB() __builtin_amdgcn_sched_barrier(0)
#define PA_PIN(x) asm volatile("" : "+v"(x))
#define PA_KEEP(x) asm volatile("" :: "v"(x))
#define PA_MF(a, b, c) __builtin_amdgcn_mfma_f32_32x32x16_bf16(a, b, c, 0, 0, 0)
#define PA_MFMA_DONE(acc0, acc1) do { float t_; asm volatile("s_nop 15\n\tv_mov_b32 %0, %1\n\tv_mov_b32 %0, %2\n\ts_nop 1" : "=&v"(t_) : "v"(acc0[15]), "v"(acc1[15])); asm volatile("" :: "v"(t_)); } while (0)
template <bool MASKED>
__device__ __forceinline__ void attn_pass_p64(f32x16 (&o)[2], const bf16* Q, const bf16* K, const bf16* VT, const unsigned* MASKb, const LAS float* bias,
                                              int q0, int nt, LAS unsigned char* lds, int tid, int wave, int lane) {
    asm volatile("" : "+v"(tid), "+v"(lane));
    const int r32 = lane & 31, hi = lane >> 5, qw0 = q0 + 32 * wave, qpos = qw0 + r32;
    bf16x8 qf[4];
#pragma unroll
    for (int s = 0; s < 4; ++s) qf[s] = *(const bf16x8*)(Q + (size_t)qpos * 1024 + 16 * s + 8 * hi);
    const int srow = 8 * wave + (lane >> 3), spc = ((lane & 7) ^ ((srow >> 1) & 7)) * 8;
    unsigned koff = (unsigned)(srow * 1024 + spc) * 2u, voff = (unsigned)(srow * M + spc) * 2u, moff = (unsigned)qpos * 512u;
    const char* Ku = uni_ptr((const char*)K); const char* Vu = uni_ptr((const char*)VT); const char* Mu = MASKED ? uni_ptr((const char*)MASKb) : nullptr;
    LAS float* wsf = (LAS float*)(lds + WSF_OFF + wave * 256);
#define PA_DK(t) do { const char* b_ = Ku + (size_t)(t) * 131072; asm volatile("" : "+s"(b_)); asm volatile("" : "+v"(koff)); \
        __builtin_amdgcn_global_load_lds((const unsigned*)(b_ + koff), (LAS unsigned*)(lds + K_OFF + ((t) & 3) * KSLOT + wave * 1024), 16, 0, 0); } while (0)
#define PA_DV(t) do { const char* b_ = Vu + (size_t)(t) * 128; asm volatile("" : "+s"(b_)); asm volatile("" : "+v"(voff)); \
        __builtin_amdgcn_global_load_lds((const unsigned*)(b_ + voff), (LAS unsigned*)(lds + V_OFF + ((t) & 3) * VSLOT + wave * 1024), 16, 0, 0); } while (0)
#define PA_DM(t) do { if (MASKED) { const char* b_ = Mu + (size_t)(16 * ((t) >> 1)); asm volatile("" : "+s"(b_)); asm volatile("" : "+v"(moff)); \
        __builtin_amdgcn_global_load_lds((const unsigned*)(b_ + moff), (LAS unsigned*)(lds + MSK_OFF + wave * 4096 + ((t) & 3) * 1024), 16, 0, 0); } } while (0)
    constexpr int NOPS = MASKED ? 3 : 2;
    asm volatile("s_waitcnt lgkmcnt(0)\n\ts_barrier" ::: "memory");
    PA_DM(0); PA_DK(0); PA_DV(0); PA_DM(1); PA_DK(1); PA_DV(1); PA_DK(2);
    int xo[4];
#pragma unroll
    for (int s = 0; s < 4; ++s) xo[s] = r32 * 128 + (((2 * s + hi) ^ ((r32 >> 1) & 7)) * 16);
    asm volatile("s_waitcnt vmcnt(1)" ::: "memory");
    __builtin_amdgcn_s_barrier();
    bf16x8 kf[8], vf[8]; v4u pw0, pw1, pw2, pw3; f32x16 pA0, pA1, pB0, pB1;
    float lsum = 0.f; bool resc = false;
    f32x16 negm;
#pragma unroll
    for (int r = 0; r < 16; ++r) { o[0][r] = 0.f; o[1][r] = 0.f; negm[r] = 0.f; }
#define PA_KLD(s, tt) do { const LAS unsigned char* kn_ = lds + K_OFF + ((tt) & 3) * KSLOT; PA_KEEP(kf[2 * (s)]); PA_KEEP(kf[2 * (s) + 1]); kf[2 * (s)] = *(const LAS bf16x8*)(kn_ + xo[s]); kf[2 * (s) + 1] = *(const LAS bf16x8*)(kn_ + xo[s] + 4096); } while (0)
#define PA_BIAS(C0, C1, tt) do { const int kv0_ = 64 * (tt); if (kv0_ + 63 + 113 > qw0) { const int dq_ = qpos - kv0_ - 4 * hi + 1; \
        _Pragma("unroll") for (int r = 0; r < 16; ++r) { const int d_ = dq_ - ((r & 3) + 8 * (r >> 2)); C0[r] += bias[med3i(d_, 0, 128)]; C1[r] += bias[med3i(d_ - 32, 0, 128)]; } } } while (0)
#define PA_ROWMAX(rm, C0, C1) do { float a_ = max3f(C0[0], C0[1], C1[0]), b_ = max3f(C0[2], C0[3], C1[1]); a_ = max3f(a_, C1[2], C1[3]); \
        _Pragma("unroll") for (int r = 4; r < 16; r += 4) { a_ = max3f(a_, C0[r], C0[r + 1]); b_ = max3f(b_, C0[r + 2], C0[r + 3]); a_ = max3f(a_, C1[r], C1[r + 1]); b_ = max3f(b_, C1[r + 2], C1[r + 3]); } \
        rm = swap_max(max3f(a_, b_, b_)); } while (0)
#define PA_EXP4(X, i) do { X[i] = __builtin_amdgcn_exp2f(X[i]); X[(i) + 1] = __builtin_amdgcn_exp2f(X[(i) + 1]); X[(i) + 2] = __builtin_amdgcn_exp2f(X[(i) + 2]); X[(i) + 3] = __builtin_amdgcn_exp2f(X[(i) + 3]); PA_PIN(X); } while (0)
#pragma unroll
    for (int s = 0; s < 4; ++s) { kf[2 * s] = *(const LAS bf16x8*)(lds + K_OFF + xo[s]); kf[2 * s + 1] = *(const LAS bf16x8*)(lds + K_OFF + xo[s] + 4096); }
    PA_SB();
    { const f32x16 z16 = {0.f, 0.f, 0.f, 0.f, 0.f, 0.f, 0.f, 0.f, 0.f, 0.f, 0.f, 0.f, 0.f, 0.f, 0.f, 0.f};
#pragma unroll
      for (int s = 0; s < 4; ++s) { pA0 = PA_MF(kf[2 * s], qf[s], s == 0 ? z16 : pA0); pA1 = PA_MF(kf[2 * s + 1], qf[s], s == 0 ? z16 : pA1); } }
    PA_SB();
    PA_DM(2); PA_DV(2); PA_DK(3);
    PA_SB();
    asm volatile("s_nop 15\n\ts_nop 7" : "+v"(pA0), "+v"(pA1));
    PA_BIAS(pA0, pA1, 0);
    { float rm; PA_ROWMAX(rm, pA0, pA1); const float m0_ = (rm == -INFINITY) ? 0.f : rm;
#pragma unroll
      for (int r = 0; r < 16; ++r) { pA0[r] -= m0_; pA1[r] -= m0_; negm[r] = -m0_; } }
    PA_EXP4(pA0, 0); PA_EXP4(pA0, 4); PA_EXP4(pA0, 8); PA_EXP4(pA0, 12); PA_EXP4(pA1, 0); PA_EXP4(pA1, 4); PA_EXP4(pA1, 8); PA_EXP4(pA1, 12);
    PA_SB();
#pragma unroll
    for (int s = 0; s < 4; ++s) { const LAS unsigned char* kn_ = lds + K_OFF + KSLOT; PA_KEEP(kf[2 * s]); PA_KEEP(kf[2 * s + 1]); kf[2 * s] = *(const LAS bf16x8*)(kn_ + xo[s]); kf[2 * s + 1] = *(const LAS bf16x8*)(kn_ + xo[s] + 4096); }
    asm volatile("s_waitcnt vmcnt(%0) lgkmcnt(0)" :: "n"(NOPS) : "memory"); __builtin_amdgcn_s_barrier();
#define PA_C(r) (((r) & 3) + 8 * ((r) >> 2))
#define PA_FIN4(X, i, w, A, B) do { if (MASKED) { X[i] = __uint_as_float(__float_as_uint(X[i]) & bfe1(w, PA_C(i))); X[(i) + 1] = __uint_as_float(__float_as_uint(X[(i) + 1]) & bfe1(w, PA_C((i) + 1))); \
            X[(i) + 2] = __uint_as_float(__float_as_uint(X[(i) + 2]) & bfe1(w, PA_C((i) + 2))); X[(i) + 3] = __uint_as_float(__float_as_uint(X[(i) + 3]) & bfe1(w, PA_C((i) + 3))); } \
        sa_ = fadd_s(sa_, X[i]); sb_ = fadd_s(sb_, X[(i) + 1]); sa_ = fadd_s(sa_, X[(i) + 2]); sb_ = fadd_s(sb_, X[(i) + 3]); A = cvtpk(X[i], X[(i) + 1]); B = cvtpk(X[(i) + 2], X[(i) + 3]); } while (0)
#define PA_VLD(i, vb) do { PA_KEEP(vf[i]); vf[i] = *(const LAS bf16x8*)((vb) + xo[(i) & 3] + ((i) >> 2) * 4096); } while (0)
#define PA_GAPA(i, MFST, X, e, w, PW, A, B) do { PA_VLD(i, vb_); MFST; PA_KEEP(PW); PA_FIN4(X, e, w, PW.A, PW.B); PA_PIN(PW); PA_PIN(sa_); PA_PIN(sb_); PA_SB(); } while (0)
#define PA_MASKW(tt) u32x2 mw_ = {0u, 0u}; if (MASKED) mw_ = *(const LAS u32x2*)(lds + MSK_OFF + wave * 4096 + ((tt) & 3) * 1024 + r32 * 16 + ((tt) & 1) * 8); const unsigned w0_ = mw_.x >> (4 * hi), w1_ = mw_.y >> (4 * hi)
#define PA_PVB(j) __builtin_bit_cast(bf16x8, pw##j)
#define PA_STEP(C0, C1, P0, P1, tt) do { const int t_ = (tt); \
        { \
            const LAS unsigned char* vb_ = lds + V_OFF + ((t_ - 1) & 3) * VSLOT; PA_MASKW(t_ - 1); float sa_ = 0.f, sb_ = 0.f; \
            const f32x16 z16 = {0.f, 0.f, 0.f, 0.f, 0.f, 0.f, 0.f, 0.f, 0.f, 0.f, 0.f, 0.f, 0.f, 0.f, 0.f, 0.f}; \
            PA_SB(); \
            PA_GAPA(0, C0 = PA_MF(kf[0], qf[0], negm), P0, 0, w0_, pw0, x, y); \
            PA_GAPA(4, C1 = PA_MF(kf[1], qf[0], negm), P0, 4, w0_, pw0, z, w); \
            PA_GAPA(1, C0 = PA_MF(kf[2], qf[1], C0), P0, 8, w0_, pw1, x, y); \
            PA_GAPA(5, C1 = PA_MF(kf[3], qf[1], C1), P0, 12, w0_, pw1, z, w); \
            PA_GAPA(2, C0 = PA_MF(kf[4], qf[2], C0), P1, 0, w1_, pw2, x, y); \
            PA_GAPA(6, C1 = PA_MF(kf[5], qf[2], C1), P1, 4, w1_, pw2, z, w); \
            PA_GAPA(3, C0 = PA_MF(kf[6], qf[3], C0), P1, 8, w1_, pw3, x, y); \
            PA_GAPA(7, C1 = PA_MF(kf[7], qf[3], C1), P1, 12, w1_, pw3, z, w); \
            lsum += sa_ + sb_; \
            if (t_ + 2 < nt) { PA_DM(t_ + 2); PA_DV(t_ + 2); } if (t_ + 3 < nt) PA_DK(t_ + 3); \
            PA_SB(); \
            asm volatile("s_nop 3" : "+v"(C0), "+v"(C1));     \
            _Pragma("unroll") for (int i = 0; i < 8; ++i) PA_KEEP(kf[i]); _Pragma("unroll") for (int i = 0; i < 4; ++i) PA_KEEP(qf[i]);     \
            PA_BIAS(C0, C1, t_); \
            { float rm_; PA_ROWMAX(rm_, C0, C1); resc = false; \
              if (__any(rm_ > 8.f)) { const float dl_ = fmaxf(rm_, 0.f), f_ = __builtin_amdgcn_exp2f(-dl_); lsum *= f_; if (hi == 0) wsf[r32] = f_; resc = true; \
                  _Pragma("unroll") for (int r = 0; r < 16; ++r) { C0[r] -= dl_; C1[r] -= dl_; negm[r] -= dl_; } } } \
            PA_SB(); \
            o[0] = PA_MF(PA_PVB(0), vf[0], o[0]); PA_EXP4(C0, 0); PA_SB(); \
            o[1] = PA_MF(PA_PVB(0), vf[4], o[1]); PA_EXP4(C0, 4); PA_SB(); \
            if (t_ + 1 < nt) PA_KLD(0, t_ + 1); o[0] = PA_MF(PA_PVB(1), vf[1], o[0]); PA_EXP4(C0, 8); PA_SB(); \
            if (t_ + 1 < nt) PA_KLD(1, t_ + 1); o[1] = PA_MF(PA_PVB(1), vf[5], o[1]); PA_EXP4(C0, 12); PA_SB(); \
            if (t_ + 1 < nt) PA_KLD(2, t_ + 1); o[0] = PA_MF(PA_PVB(2), vf[2], o[0]); PA_EXP4(C1, 0); PA_SB(); \
            if (t_ + 1 < nt) PA_KLD(3, t_ + 1); o[1] = PA_MF(PA_PVB(2), vf[6], o[1]); PA_EXP4(C1, 4); PA_SB(); \
            o[0] = PA_MF(PA_PVB(3), vf[3], o[0]); PA_EXP4(C1, 8); PA_SB(); \
            o[1] = PA_MF(PA_PVB(3), vf[7], o[1]); PA_EXP4(C1, 12); PA_SB(); \
        } \
        if (t_ + 3 < nt) asm volatile("s_waitcnt vmcnt(%0) lgkmcnt(0)" :: "n"(NOPS) : "memory"); \
        else if (t_ + 2 < nt) asm volatile("s_waitcnt vmcnt(%0) lgkmcnt(0)" :: "n"(NOPS - 1) : "memory"); \
        else asm volatile("s_waitcnt vmcnt(0) lgkmcnt(0)" ::: "memory"); \
        __builtin_amdgcn_s_barrier(); \
        if (resc) { resc = false; _Pragma("unroll") for (int r = 0; r < 16; ++r) { const float fr_ = wsf[crow(r, hi)]; o[0][r] *= fr_; o[1][r] *= fr_; } LDS_WAIT(); } \
    } while (0)
#define PA_DRAIN(P0, P1, tt) do { const LAS unsigned char* vb_ = lds + V_OFF + ((tt) & 3) * VSLOT; PA_MASKW(tt); float sa_ = 0.f, sb_ = 0.f; \
        PA_MFMA_DONE(o[0], o[1]); PA_SB(); \
        _Pragma("unroll") for (int i = 0; i < 8; ++i) PA_VLD(i, vb_); \
        asm volatile("s_waitcnt lgkmcnt(0)\n\ts_barrier" : "+v"(vf[0]), "+v"(vf[1]), "+v"(vf[2]), "+v"(vf[3]), "+v"(vf[4]), "+v"(vf[5]), "+v"(vf[6]), "+v"(vf[7]) :: "memory");     \
        PA_KEEP(pw0); PA_KEEP(pw1); PA_KEEP(pw2); PA_KEEP(pw3); \
        PA_FIN4(P0, 0, w0_, pw0.x, pw0.y); PA_FIN4(P0, 4, w0_, pw0.z, pw0.w); PA_FIN4(P0, 8, w0_, pw1.x, pw1.y); PA_FIN4(P0, 12, w0_, pw1.z, pw1.w); \
        PA_FIN4(P1, 0, w1_, pw2.x, pw2.y); PA_FIN4(P1, 4, w1_, pw2.z, pw2.w); PA_FIN4(P1, 8, w1_, pw3.x, pw3.y); PA_FIN4(P1, 12, w1_, pw3.z, pw3.w); \
        lsum += sa_ + sb_; PA_SB(); \
        o[0] = PA_MF(PA_PVB(0), vf[0], o[0]); o[1] = PA_MF(PA_PVB(0), vf[4], o[1]); o[0] = PA_MF(PA_PVB(1), vf[1], o[0]); o[1] = PA_MF(PA_PVB(1), vf[5], o[1]); \
        o[0] = PA_MF(PA_PVB(2), vf[2], o[0]); o[1] = PA_MF(PA_PVB(2), vf[6], o[1]); o[0] = PA_MF(PA_PVB(3), vf[3], o[0]); o[1] = PA_MF(PA_PVB(3), vf[7], o[1]); PA_SB(); \
        PA_MFMA_DONE(o[0], o[1]); PA_SB();     \
        PA_KEEP(pw0); PA_KEEP(pw1); PA_KEEP(pw2); PA_KEEP(pw3); _Pragma("unroll") for (int i = 0; i < 8; ++i) PA_KEEP(vf[i]); } while (0)
    int t = 1;
    for (; t + 1 < nt; t += 2) { PA_STEP(pB0, pB1, pA0, pA1, t); PA_STEP(pA0, pA1, pB0, pB1, t + 1); }
    PA_STEP(pB0, pB1, pA0, pA1, nt - 1);
    PA_DRAIN(pB0, pB1, nt - 1);
#undef PA_DK
#undef PA_DV
#undef PA_DM
#undef PA_KLD
#undef PA_BIAS
#undef PA_ROWMAX
#undef PA_EXP4
#undef PA_C
#undef PA_FIN4
#undef PA_VLD
#undef PA_GAPA
#undef PA_MASKW
#undef PA_PVB
#undef PA_STEP
#undef PA_DRAIN
    lsum = swap_sum(lsum);
    if (hi == 0) wsf[r32] = __builtin_amdgcn_rcpf(lsum);
    LDS_WAIT();
#pragma unroll
    for (int r = 0; r < 16; ++r) { const float fr = wsf[crow(r, hi)]; o[0][r] *= fr; o[1][r] *= fr; }
    LDS_WAIT();
}
#undef PA_SB
#undef PA_PIN
#undef PA_KEEP
#undef PA_MF
template <int DV>
__device__ __forceinline__ void store_tile(const f32x16 (&o)[DV / 32], bf16* O, LAS unsigned char* lds, int wave, int lane) {
    asm volatile("" : "+v"(lane));
    const int r32 = lane & 31, hi = lane >> 5;
    LAS bf16* stg = (LAS bf16*)(lds + OST_OFF + wave * 8192);
#pragma unroll
    for (int d0 = 0; d0 < DV / 32; ++d0)
#pragma unroll
        for (int r = 0; r < 16; ++r) stg[crow(r, hi) * DV + 32 * d0 + r32] = (bf16)f2bf(o[d0][r]);
    LDS_WAIT();
    constexpr int CPR = DV / 8;
#pragma unroll
    for (int i = 0; i < 32 * CPR / 64; ++i) { const int id = i * 64 + lane, row = id / CPR, ch = id % CPR;
        const v4u v = *(const LAS v4u*)(stg + row * DV + ch * 8); *(v4u*)(O + (size_t)row * 1024 + ch * 8) = v; }
    LDS_WAIT();
}
}

__device__ __forceinline__ void dsa_unit(const Ptrs& P, const LAS float* biasT, int b, int h, int qb, LAS unsigned char* lds, int tid, int wave, int lane) {
    asm volatile("" : "+v"(lane));
    const int q0 = 256 * qb, qpos = q0 + 32 * wave + (lane & 31);
    att::f32x16 o[2];
    att::attn_pass_p64<true>(o, P.QO + (size_t)b * SEQ * 1024 + h * 64, P.KK + (size_t)b * SEQ * 1024 + h * 64, P.VT + (size_t)(h * 64) * M + (size_t)b * SEQ,
                             P.MASK + (size_t)(b * SEQ) * 128, biasT + h * BIAS_LD, q0, 4 * (qb + 1), lds, tid, wave, lane);
    att::store_tile<64>(o, P.MIX + (size_t)(b * SEQ + q0 + 32 * wave) * 1024 + h * 64, lds, wave, lane);
}
__device__ __forceinline__ void diff_unit(const Ptrs& P, const LAS float* biasT, const float* subln, float lam_full, float lam_init, int b, int hd, int qb, LAS unsigned char* lds, int tid, int wave, int lane) {
    asm volatile("" : "+v"(lane));
    const int q0 = 256 * qb, r32 = lane & 31;
    const bf16* Qb = P.QO + (size_t)b * SEQ * 1024 + 512 + hd * 128; const bf16* Kb = P.KK + (size_t)b * SEQ * 1024 + 512 + hd * 128; const bf16* Vb = P.VT + (size_t)(512 + hd * 128) * M + (size_t)b * SEQ;
    att::f32x16 o[4];
    att::attn_pass<128, false>(o, Qb, Kb, Vb, nullptr, biasT + (8 + hd) * BIAS_LD, q0, 4 * (qb + 1), lds, tid, wave, lane);
    bf16* Ow = P.MIX + (size_t)(b * SEQ + q0 + 32 * wave) * 1024 + 512 + hd * 128;
    att::store_tile<128>(o, Ow, lds, wave, lane);
    att::attn_pass<128, false>(o, Qb + 64, Kb + 64, Vb, nullptr, biasT + (8 + hd) * BIAS_LD, q0, 4 * (qb + 1), lds, tid, wave, lane);
    LAS bf16* stg = (LAS bf16*)(lds + att::OST_OFF + wave * 8192);
    asm volatile("s_waitcnt vmcnt(0)" ::: "memory");
    { v4u pk[8];
#pragma unroll
      for (int i = 0; i < 8; ++i) { const int id = i * 64 + lane, row = id >> 4, ch = id & 15; pk[i] = *(const v4u*)(Ow + (size_t)row * 1024 + ch * 8); }
      asm volatile("s_waitcnt vmcnt(0)" ::: "memory");
#pragma unroll
      for (int i = 0; i < 8; ++i) { const int id = i * 64 + lane, row = id >> 4, ch = id & 15; *(LAS v4u*)(stg + row * 128 + ch * 8) = pk[i]; } }
    LDS_WAIT();
    float ss[16];
    { const int hi = lane >> 5;
#pragma unroll
      for (int r = 0; r < 16; ++r) { float s = 0.f;
#pragma unroll
        for (int d0 = 0; d0 < 4; ++d0) { const float d = bf2f(stg[att::crow(r, hi) * 128 + 32 * d0 + r32]) - lam_full * o[d0][r]; o[d0][r] = d; s += d * d; }
        ss[r] = s; } }
    LDS_WAIT();
    float g[4];
#pragma unroll
    for (int d0 = 0; d0 < 4; ++d0) g[d0] = subln[32 * d0 + r32] * (1.f - lam_init);
#pragma unroll
    for (int r = 0; r < 16; ++r) { float s = ss[r];
#pragma unroll
        for (int m = 1; m < 32; m <<= 1) s += __shfl_xor(s, m);
        const float rn = __builtin_amdgcn_rsqf(s * (1.f / 128.f) + 1e-6f);
#pragma unroll
        for (int d0 = 0; d0 < 4; ++d0) o[d0][r] *= rn * g[d0]; }
    att::store_tile<128>(o, P.MIX + (size_t)(b * SEQ + q0 + 32 * wave) * 1024 + 512 + hd * 128, lds, wave, lane);
}
__device__ __forceinline__ void attn_phase(const Ptrs& P, const LAS float* biasT, const float* subln, float lam_full, float lam_init, LAS unsigned char* lds, int bid, int G, int tid, int wave, int lane) {
    for (int vb = bid; vb < 256; vb += G) {
        const int vcu = (vb & 7) * 32 + (vb >> 3), g = vcu >> 2, k = vcu & 3;
        for (int j = 0; j < 2; ++j) { const int bh = 2 * g + j;
            for (int i = 0; i < 4; ++i) { const int qb = (i == 0) ? 15 - k : (i == 1) ? k : (i == 2) ? 11 - k : 4 + k; dsa_unit(P, biasT, bh >> 3, bh & 7, qb, lds, tid, wave, lane); } }
        for (int i = 0; i < 4; ++i) { const int qb = (i == 0) ? 15 - k : (i == 1) ? k : (i == 2) ? 11 - k : 4 + k; diff_unit(P, biasT, subln, lam_full, lam_init, g >> 2, g & 3, qb, lds, tid, wave, lane); }
    }
}

struct Args { const float* in[12]; float* out; unsigned char* ws; int ph_lo, ph_hi; };
__global__ void __launch_bounds__(NWAVES * 64, 2) fwd_kernel(Args args) {
    extern __shared__ __attribute__((aligned(16))) unsigned char lds_raw[];
    LAS unsigned char* lds = (LAS unsigned char*)lds_raw;
    volatile LAS unsigned* MISC = (volatile LAS unsigned*)(lds + MISC_OFF);
    const int tid = threadIdx.x;
#define ENTER() int tidl_ = threadIdx.x; asm volatile("" : "+v"(tidl_)); int bid_ = blockIdx.x, G = gridDim.x; asm volatile("" : "+s"(bid_), "+s"(G)); \
    const int lane = tidl_ & 63, wave = __builtin_amdgcn_readfirstlane(tidl_ >> 6), gw = bid_ * NWAVES + wave, NGW = G * NWAVES; (void)lane; (void)gw; (void)NGW; \
    LAS float* sc = (LAS float*)(lds + RING_OFF + wave * 16384); LAS float* qs = (LAS float*)(lds + WSCR_OFF + wave * 2048); const LAS float* biasT = (const LAS float*)(lds + BIAS_OFF); (void)sc; (void)qs; (void)biasT;
    typedef const __attribute__((address_space(4))) Args* KArgs;
    KArgs kargs = (KArgs)__builtin_amdgcn_kernarg_segment_ptr();
#define MKP() Ptrs P; { KArgs ka_ = kargs; asm volatile("" : "+s"(ka_)); unsigned char* ws = ka_->ws; \
    P.x = ka_->in[0]; P.attn_norm = ka_->in[1]; P.w_in = ka_->in[2]; P.diff_lambda = ka_->in[3]; P.diff_subln = ka_->in[4]; P.w_out = ka_->in[5]; P.ffn_norm = ka_->in[6]; \
    P.w_gate = ka_->in[7]; P.w_up = ka_->in[8]; P.w_down = ka_->in[9]; P.rel_bias = ka_->in[10]; P.final_norm = ka_->in[11]; P.out = ka_->out; \
    P.WIN = (bf16*)(ws + WS_WIN); P.WOUT = (bf16*)(ws + WS_WOUT); P.WGU = (bf16*)(ws + WS_WGU); P.WDN = (bf16*)(ws + WS_WDN); P.IK = (bf16*)(ws + WS_IK); \
    P.XB = (bf16*)(ws + WS_XB); P.QO = (bf16*)(ws + WS_QO); P.KK = (bf16*)(ws + WS_KK); P.VT = (bf16*)(ws + WS_VT); P.IQ = (bf16*)(ws + WS_IQ); P.ACT = (bf16*)(ws + WS_ACT); P.MIX = (bf16*)(ws + WS_MIX); \
    P.SS = (float*)(ws + WS_SS); P.IW = (float*)(ws + WS_IW); P.MASK = (unsigned*)(ws + WS_MASK); }
    gu32* ctl = (gu32*)(kargs->ws + WS_CTL);
    for (int u = tid; u < (LDS_BYTES - MISC_OFF) / 4; u += NWAVES * 64) ((LAS unsigned*)(lds + MISC_OFF))[u] = 0u;
    { MKP(); ENTER(); LAS float* bt = (LAS float*)(lds + BIAS_OFF);
      for (int i = tid; i < 12 * BIAS_LD; i += NWAVES * 64) { const int h = i / BIAS_LD, e = i % BIAS_LD; float v = 0.f;
          if (e == 0) v = -INFINITY; else if (e <= 128) v = (P.rel_bias[(int)T5_BUCKET[e - 1] * 12 + h] - P.rel_bias[31 * 12 + h]) * 1.4426950408889634f;
          bt[i] = v; } }
    __syncthreads();
    XcdBarrier bar; bar.bar = (unsigned*)(ctl + CW_BAR); bar.x = 0; bar.st = nullptr;
    if (!MK_PER_PHASE) bar = xcd_barrier_post((unsigned*)(ctl + CW_BAR), MISC + 8);
    const int lo = kargs->ph_lo, hi = kargs->ph_hi;
#define IN(k) (lo <= (k) && (k) < hi)
#define SEAM(k) do { if (IN(k) && IN((k) + 1)) xcd_barrier(bar); } while (0)

    if (IN(0)) { MKP(); ENTER(); prologue(P, lds, gw, NGW, wave, lane); }
    SEAM(0);
    for (int l = 0; l < DEPTH; ++l) {
        const int p0 = 1 + 6 * l;
        if (IN(p0)) {
            MKP(); ENTER();
            { pg8::Gemm g{P.XB, P.WIN + (size_t)l * NIN * DM, M, NIN_MAIN, DM}; pg8::StaticOrder S; S.init(M, NIN_MAIN, G, bid_);
              pg8::EpiInProj E{P.QO, P.KK, P.IQ, P.IK, P.IW, P.SS};
              pg8::gemm_phase<pg8::EpiInProj, pg8::StaticOrder, true, true>(lds + RING_OFF, g, S, E); }
            { pg8::Gemm g{P.WIN + ((size_t)l * NIN + NIN_MAIN) * DM, P.XB, NIN_V, M, DM}; pg8::StaticOrder S; S.init(NIN_V, M, G, bid_);
              pg8::EpiVT E{P.VT, P.SS};
              pg8::gemm_phase<pg8::EpiVT, pg8::StaticOrder, true, true>(lds + RING_OFF, g, S, E); }
        }
        SEAM(p0);
        if (IN(p0 + 1)) {
            MKP(); ENTER();
            idx::idx_phase<0>(P, lds, bid_, G, tidl_, wave, lane);
            if (PROBE_IDX > 1) idx::idx_phase<PROBE_IDX - 1>(P, lds, bid_, G, tidl_, wave, lane);
        }
        SEAM(p0 + 1);
        if (IN(p0 + 2)) {
            MKP(); ENTER();
            const float lam_init = 0.8f - 0.6f * __expf(-0.3f * (float)l);
            const float* lam = P.diff_lambda + l * 256;
            const float lam_full = __expf(wave_sum(lam[lane] * lam[64 + lane])) - __expf(wave_sum(lam[128 + lane] * lam[192 + lane])) + lam_init;
            for (int rep = 0; rep < PROBE_ATT; ++rep) attn_phase(P, biasT, P.diff_subln + l * 128, lam_full, lam_init, lds, bid_, G, tidl_, wave, lane);
        }
        SEAM(p0 + 2);
        if (IN(p0 + 3)) {
            MKP(); ENTER();
            pg8::Gemm g{P.MIX, P.WOUT + (size_t)l * DM * DM, M, DM, DM}; pg8::StaticOrder S; S.init(M, DM, G, bid_);
            pg8::EpiRes E{l == 0 ? P.x : nullptr, P.XB, P.SS};
            pg8::gemm_phase<pg8::EpiRes, pg8::StaticOrder, true, true>(lds + RING_OFF, g, S, E);
        }
        SEAM(p0 + 3);
        if (IN(p0 + 4)) {
            MKP(); ENTER();
            pg8::Gemm g{P.XB, P.WGU + (size_t)l * NGU * DM, M, NGU, DM}; pg8::StaticOrder S; S.init(M, NGU, G, bid_);
            pg8::EpiGateUp E{P.ACT, P.SS};
            for (int rep = 0; rep < PROBE_GU; ++rep) pg8::gemm_phase<pg8::EpiGateUp, pg8::StaticOrder, true, true>(lds + RING_OFF, g, S, E);
        }
        SEAM(p0 + 4);
        if (IN(p0 + 5)) {
            MKP(); ENTER();
            pg8::Gemm g{P.ACT, P.WDN + (size_t)l * DM * DFF, M, DM, DFF}; pg8::StaticOrder S; S.init(M, DM, G, bid_);
            pg8::EpiRes E{nullptr, P.XB, P.SS};
            pg8::gemm_phase<pg8::EpiRes, pg8::StaticOrder, true, true>(lds + RING_OFF, g, S, E);
        }
        SEAM(p0 + 5);
    }
    if (IN(NPH - 1)) { MKP(); ENTER(); final_norm_phase(P, gw, NGW, lane); }
#undef IN
#undef MKP
#undef ENTER
#undef SEAM
}

extern "C" void kernel_launch(void* const* d_in, const int* in_sizes, int n_in, void* d_out, int out_size, void* d_ws, size_t ws_size, hipStream_t stream) {
    static int grid = 0;
    if (grid == 0) {
        if (n_in != 12 || in_sizes[0] != M * DM || out_size != M * DM || ws_size < WS_END) { fprintf(stderr, "kernel_launch: unexpected shapes (n_in %d, in0 %d, out %d, ws %zu); nothing launched\n", n_in, n_in > 0 ? in_sizes[0] : -1, out_size, ws_size); grid = -1; return; }
        int dev = 0, cus = 0, per_cu = 0;
        if (hipGetDevice(&dev) != hipSuccess || hipDeviceGetAttribute(&cus, hipDeviceAttributeMultiprocessorCount, dev) != hipSuccess) { grid = -1; return; }
        if (hipFuncSetAttribute((const void*)fwd_kernel, hipFuncAttributeMaxDynamicSharedMemorySize, LDS_BYTES) != hipSuccess) { fprintf(stderr, "kernel_launch: hipFuncSetAttribute failed\n"); grid = -1; return; }
        if (hipOccupancyMaxActiveBlocksPerMultiprocessor(&per_cu, (const void*)fwd_kernel, NWAVES * 64, LDS_BYTES) != hipSuccess || per_cu < 1)
            fprintf(stderr, "kernel_launch: note: occupancy query reports %d workgroups per CU\n", per_cu);
        (void)hipGetLastError();
        grid = cus;
    }
    if (grid < 0) return;
    if (hipMemsetAsync((char*)d_ws + WS_CTL, 0, CTL_ZERO_BYTES, stream) != hipSuccess) return;
    Args a{};
    for (int i = 0; i < 12; ++i) a.in[i] = (const float*)d_in[i];
    a.out = (float*)d_out; a.ws = (unsigned char*)d_ws;
#if MK_PER_PHASE
    for (int k = 0; k < NPH; ++k) { a.ph_lo = k; a.ph_hi = k + 1; hipLaunchKernelGGL(fwd_kernel, dim3(grid), dim3(NWAVES * 64), LDS_BYTES, stream, a); }
#else
    a.ph_lo = 0; a.ph_hi = NPH;
    hipLaunchKernelGGL(fwd_kernel, dim3(grid), dim3(NWAVES * 64), LDS_BYTES, stream, a);
#endif
    const hipError_t le = hipPeekAtLastError();
    if (le != hipSuccess) fprintf(stderr, "kernel_launch: launch failed: %s\n", hipGetErrorName(le));
}
```
